# Optimizing an MI355X kernel written in HIP

```python
import math
import jax
import jax.numpy as jnp
from jax import lax
import numpy as np

D_MODEL = 1024
BATCH = 2
SEQ = 8192
DEPTH = 2

CTX_LEN = 256
GRID_W = 64
HEAD_DIM = 64
BRANCH_W = 512
N_BRANCH = 4
BLOCK = 128
A_HEADS = 8
A_KV = 2
A_WINDOW = 128
B_HEADS = 8
NB_ROWS = 8
NB_COLS = 16
C_HEADS = 8
C_KV = 2
D_HEADS = 4
D_HEAD_DIM = 64
ROPE_THETA = 10000.0
EPS = 1e-6
NEG_INF = -1e30

SPLIT_SIZES = (
    A_HEADS * HEAD_DIM, A_KV * HEAD_DIM, A_KV * HEAD_DIM, BRANCH_W,
    B_HEADS * HEAD_DIM, B_HEADS * HEAD_DIM, B_HEADS * HEAD_DIM, BRANCH_W,
    C_HEADS * HEAD_DIM, C_KV * HEAD_DIM, C_KV * HEAD_DIM, BRANCH_W,
    D_HEADS * 2 * D_HEAD_DIM, D_HEADS * 2 * D_HEAD_DIM, D_HEADS * 2 * D_HEAD_DIM, BRANCH_W,
    N_BRANCH * D_MODEL,
)
SPLIT_POINTS = tuple(sum(SPLIT_SIZES[: i + 1]) for i in range(len(SPLIT_SIZES) - 1))
IN_COLS = sum(SPLIT_SIZES)

kernel_name = "hybrid_gated_dit_block"


def rms_norm(x, gain):
    xf = x.astype(jnp.float32)
    y = xf * lax.rsqrt(jnp.mean(xf * xf, axis=-1, keepdims=True) + EPS)
    return (y * gain.astype(jnp.float32)).astype(x.dtype)


def split_heads(t, n, tail=(HEAD_DIM,)):
    return t.reshape(t.shape[:2] + (n,) + tuple(tail))


def axial_rope_tables(n, dtype):
    t = jnp.arange(n, dtype=jnp.int32)
    pos = jnp.stack([t // GRID_W, t % GRID_W], axis=-1).astype(jnp.float32)
    n_freq = HEAD_DIM // 4
    freqs = ROPE_THETA ** (-jnp.arange(n_freq, dtype=jnp.float32) / n_freq)
    ang = pos[:, :, None] * freqs[None, None, :]
    ang = jnp.concatenate([ang, ang], axis=-1).reshape(n, HEAD_DIM)
    return jnp.cos(ang).astype(dtype), jnp.sin(ang).astype(dtype)


def rotate_half_axial(x):
    xa = x.reshape(x.shape[:-1] + (2, 2, HEAD_DIM // 4))
    return jnp.stack([-xa[..., 1, :], xa[..., 0, :]], axis=-2).reshape(x.shape)


def apply_rope(x, cos, sin):
    shp = (1, x.shape[1]) + (1,) * (x.ndim - 3) + (HEAD_DIM,)
    return x * cos.reshape(shp) + rotate_half_axial(x) * sin.reshape(shp)


def qk_prep(t, n, gain, cos=None, sin=None, tail=(HEAD_DIM,)):
    t = rms_norm(split_heads(t, n, tail), gain)
    if cos is not None:
        t = apply_rope(t, cos, sin)
    return t


def attend_sets(q, kv_sets, sink=None):
    scale = HEAD_DIM ** -0.5
    logits = [jnp.einsum('bqkgd,bjkd->bkgqj', q, k, preferred_element_type=jnp.float32) * scale
              for k, _ in kv_sets]
    if sink is not None:
        kv, g = q.shape[2], q.shape[3]
        logits.append(jnp.broadcast_to(sink.astype(jnp.float32).reshape(1, kv, g, 1, 1),
                                       logits[0].shape[:-1] + (1,)))
    p = jax.nn.softmax(jnp.concatenate(logits, axis=-1), axis=-1)
    out, off = None, 0
    for k, v in kv_sets:
        n = k.shape[1]
        term = jnp.einsum('bkgqj,bjkd->bqkgd', p[..., off:off + n].astype(v.dtype), v)
        out = term if out is None else out + term
        off += n
    return out


def diff_attend_sets(q, kv_sets, lam):
    scale = D_HEAD_DIM ** -0.5
    logits = [jnp.einsum('bqhcd,bjhcd->bhcqj', q, k, preferred_element_type=jnp.float32) * scale
              for k, _ in kv_sets]
    p = jax.nn.softmax(jnp.concatenate(logits, axis=-1), axis=-1)
    pd = p[:, :, 0] - lam * p[:, :, 1]
    out, off = None, 0
    for k, v in kv_sets:
        n = k.shape[1]
        term = jnp.einsum('bhqj,bjhe->bqhe', pd[..., off:off + n].astype(v.dtype), v)
        out = term if out is None else out + term
        off += n
    return out


def diff_lambda(lam, lam_init):
    lf = lam.astype(jnp.float32)
    return jnp.exp(jnp.sum(lf[0] * lf[1])) - jnp.exp(jnp.sum(lf[2] * lf[3])) + lam_init


def finish_diff(o, gain, lam_init):
    return (rms_norm(o, gain) * (1.0 - lam_init)).reshape(o.shape[:2] + (-1,))


def window_sink_attention(q, k, v, kc, vc, sink):
    bsz, seq = q.shape[:2]
    nblk = seq // BLOCK
    g = A_HEADS // A_KV
    scale = HEAD_DIM ** -0.5
    qb = q.reshape(bsz, nblk, BLOCK, A_KV, g, HEAD_DIM)

    def band(t):
        tp = jnp.pad(t, ((0, 0), (BLOCK, BLOCK), (0, 0), (0, 0)))
        tp = tp.reshape(bsz, nblk + 2, BLOCK, A_KV, HEAD_DIM)
        return jnp.concatenate([tp[:, :-2], tp[:, 1:-1], tp[:, 2:]], axis=2)

    kw, vw = band(k), band(v)
    nw = 3 * BLOCK
    s_win = jnp.einsum('bnqkgd,bnjkd->bnkgqj', qb, kw, preferred_element_type=jnp.float32) * scale
    rel = jnp.arange(nw)[None, :] - BLOCK - jnp.arange(BLOCK)[:, None]
    kpos = jnp.arange(nblk)[:, None] * BLOCK - BLOCK + jnp.arange(nw)[None, :]
    mask = (jnp.abs(rel) <= A_WINDOW)[None] & ((kpos >= 0) & (kpos < seq))[:, None, :]
    s_win = jnp.where(mask[None, :, None, None], s_win, NEG_INF)
    s_ctx = jnp.einsum('bnqkgd,bjkd->bnkgqj', qb, kc, preferred_element_type=jnp.float32) * scale
    s_sink = jnp.broadcast_to(sink.astype(jnp.float32).reshape(1, 1, A_KV, g, 1, 1),
                              s_win.shape[:-1] + (1,))
    p = jax.nn.softmax(jnp.concatenate([s_win, s_ctx, s_sink], axis=-1), axis=-1)
    n_ctx = kc.shape[1]
    o = (jnp.einsum('bnkgqj,bnjkd->bnqkgd', p[..., :nw].astype(v.dtype), vw)
         + jnp.einsum('bnkgqj,bjkd->bnqkgd', p[..., nw:nw + n_ctx].astype(v.dtype), vc))
    return o.reshape(bsz, seq, A_HEADS * HEAD_DIM)


def neighborhood_attention(q, k, v, kc, vc, rpb):
    bsz, seq = q.shape[:2]
    rows = seq // GRID_W
    kr = min(NB_ROWS, rows)
    scale = HEAD_DIM ** -0.5
    qg = q.reshape(bsz, rows, GRID_W, B_HEADS, HEAD_DIM)
    r = jnp.arange(rows)
    rstart = jnp.clip(r - kr // 2, 0, rows - kr)
    ridx = rstart[:, None] + jnp.arange(kr)[None, :]
    krows = k.reshape(bsz, rows, GRID_W, B_HEADS, HEAD_DIM)[:, ridx]
    vrows = v.reshape(bsz, rows, GRID_W, B_HEADS, HEAD_DIM)[:, ridx]
    dr = ridx - r[:, None] + (NB_ROWS - 1)
    span = 2 * NB_COLS
    n_win = kr * span
    outs = []
    for c0 in range(0, GRID_W, NB_COLS):
        start = min(max(c0 - NB_COLS // 2, 0), GRID_W - span)
        qcol = c0 + jnp.arange(NB_COLS)
        kcol = start + jnp.arange(span)
        cstart = jnp.clip(qcol - NB_COLS // 2, 0, GRID_W - NB_COLS)
        colmask = (kcol[None, :] >= cstart[:, None]) & (kcol[None, :] < cstart[:, None] + NB_COLS)
        dc = jnp.clip(kcol[None, :] - qcol[:, None], -(NB_COLS - 1), NB_COLS - 1) + (NB_COLS - 1)
        bias = rpb[:, dr[:, None, :, None], dc[None, :, None, :]]
        bias = jnp.moveaxis(bias, 0, 1).astype(jnp.float32)
        qb = qg[:, :, c0:c0 + NB_COLS]
        kb = krows[:, :, :, start:start + span]
        vb = vrows[:, :, :, start:start + span]
        s = jnp.einsum('brqhd,brkjhd->brhqkj', qb, kb, preferred_element_type=jnp.float32) * scale
        s = jnp.where(colmask[:, None, :], s + bias[None], NEG_INF)
        s = s.reshape(bsz, rows, B_HEADS, NB_COLS, n_win)
        s_ctx = jnp.einsum('brqhd,bjhd->brhqj', qb, kc, preferred_element_type=jnp.float32) * scale
        p = jax.nn.softmax(jnp.concatenate([s, s_ctx], axis=-1), axis=-1)
        pw = p[..., :n_win].reshape(bsz, rows, B_HEADS, NB_COLS, kr, span).astype(v.dtype)
        o = (jnp.einsum('brhqkj,brkjhd->brqhd', pw, vb)
             + jnp.einsum('brhqj,bjhd->brqhd', p[..., n_win:].astype(v.dtype), vc))
        outs.append(o)
    return jnp.concatenate(outs, axis=2).reshape(bsz, seq, B_HEADS * HEAD_DIM)


def dense_block_attention(q, k, v, kc, vc):
    bsz, seq = q.shape[:2]
    nblk = seq // BLOCK
    qb = jnp.moveaxis(q.reshape(bsz, nblk, BLOCK, C_KV, C_HEADS // C_KV, HEAD_DIM), 1, 0)
    o = lax.map(lambda qblk: attend_sets(qblk, [(k, v), (kc, vc)]), qb)
    return jnp.moveaxis(o, 0, 1).reshape(bsz, seq, C_HEADS * HEAD_DIM)


def differential_attention(q, k, v, kc, vc, lam):
    bsz, seq = q.shape[:2]
    nblk = seq // BLOCK
    qb = jnp.moveaxis(q.reshape((bsz, nblk, BLOCK) + q.shape[2:]), 1, 0)
    o = lax.map(lambda qblk: diff_attend_sets(qblk, [(k, v), (kc, vc)], lam), qb)
    return jnp.moveaxis(o, 0, 1).reshape((bsz, seq) + o.shape[3:])


def gated_merge(branches, gate_logits, w_br_l, w_out_l):
    ys = jnp.stack(branches, axis=2)
    proj = jnp.einsum('btnw,nwd->btnd', ys, w_br_l)
    g = jax.nn.sigmoid(gate_logits.reshape(gate_logits.shape[:2] + (N_BRANCH, D_MODEL)))
    return jnp.sum(g * proj, axis=2) @ w_out_l


def setup_inputs(seed: int = 0) -> dict:
    key = jax.random.key(seed)
    ks = jax.random.split(key, 15)

    def nrm(k, shape, s):
        return jax.random.normal(k, shape, jnp.float32) * s

    return {
        "x": nrm(ks[0], (BATCH, SEQ, D_MODEL), 1.0),
        "c": nrm(ks[1], (BATCH, D_MODEL), 1.0),
        "ctx": nrm(ks[2], (BATCH, CTX_LEN, D_MODEL), 1.0),
        "c_ctx": nrm(ks[3], (D_MODEL,), 1.0),
        "norm_w": 1.0 + nrm(ks[4], (DEPTH, D_MODEL), 0.02),
        "w_ada": nrm(ks[5], (DEPTH, D_MODEL, 3 * D_MODEL), 0.5 * D_MODEL ** -0.5),
        "b_ada": nrm(ks[6], (DEPTH, 3 * D_MODEL), 0.01),
        "w_in": nrm(ks[7], (DEPTH, D_MODEL, IN_COLS), D_MODEL ** -0.5),
        "qk_gain": 1.0 + nrm(ks[8], (DEPTH, N_BRANCH, 2, HEAD_DIM), 0.02),
        "sink_a": nrm(ks[9], (DEPTH, A_HEADS), 0.5),
        "rpb_b": nrm(ks[10], (DEPTH, B_HEADS, 2 * NB_ROWS - 1, 2 * NB_COLS - 1), 0.1),
        "lam_d": nrm(ks[11], (DEPTH, 4, D_HEAD_DIM), 0.1),
        "subln_d": 1.0 + nrm(ks[12], (DEPTH, 2 * D_HEAD_DIM), 0.02),
        "w_br": nrm(ks[13], (DEPTH, N_BRANCH, BRANCH_W, D_MODEL), BRANCH_W ** -0.5),
        "w_out": nrm(ks[14], (DEPTH, D_MODEL, D_MODEL), D_MODEL ** -0.5),
    }


def reference(x, c, ctx, c_ctx, norm_w, w_ada, b_ada, w_in, qk_gain, sink_a, rpb_b, lam_d,
              subln_d, w_br, w_out):
    bsz, seq, _ = x.shape
    ctx_len = ctx.shape[1]
    cos, sin = axial_rope_tables(seq, x.dtype)
    ga = A_HEADS // A_KV
    gc = C_HEADS // C_KV
    dtail = (2, D_HEAD_DIM)
    for l in range(DEPTH):
        need_ctx = l < DEPTH - 1
        lam_init = 0.8 - 0.6 * math.exp(-0.3 * l)
        mod_x = jax.nn.silu(c) @ w_ada[l] + b_ada[l]
        mod_c = jax.nn.silu(c_ctx) @ w_ada[l] + b_ada[l]
        shift_x, scale_x, gate_x = jnp.split(mod_x[:, None, :], 3, axis=-1)
        shift_c, scale_c, gate_c = jnp.split(mod_c[None, None, :], 3, axis=-1)
        hx = rms_norm(x, norm_w[l]) * (1.0 + scale_x) + shift_x
        hc = rms_norm(ctx, norm_w[l]) * (1.0 + scale_c) + shift_c
        px = jnp.split(hx @ w_in[l], SPLIT_POINTS, axis=-1)
        pc = jnp.split(hc @ w_in[l], SPLIT_POINTS, axis=-1)
        g = qk_gain[l]
        lam = diff_lambda(lam_d[l], lam_init)

        ka_c = qk_prep(pc[1], A_KV, g[0, 1])
        va_c = split_heads(pc[2], A_KV)
        kb_c = qk_prep(pc[5], B_HEADS, g[1, 1])
        vb_c = split_heads(pc[6], B_HEADS)
        kc_c = qk_prep(pc[9], C_KV, g[2, 1])
        vc_c = split_heads(pc[10], C_KV)
        kd_c = qk_prep(pc[13], D_HEADS, g[3, 1], tail=dtail)
        vd_c = split_heads(pc[14], D_HEADS, (2 * D_HEAD_DIM,))

        qa = qk_prep(px[0], A_HEADS, g[0, 0], cos, sin)
        ka = qk_prep(px[1], A_KV, g[0, 1], cos, sin)
        va = split_heads(px[2], A_KV)
        y_a = window_sink_attention(qa, ka, va, ka_c, va_c, sink_a[l])
        qb = qk_prep(px[4], B_HEADS, g[1, 0])
        kb = qk_prep(px[5], B_HEADS, g[1, 1])
        vb = split_heads(px[6], B_HEADS)
        y_b = neighborhood_attention(qb, kb, vb, kb_c, vb_c, rpb_b[l])
        qc = qk_prep(px[8], C_HEADS, g[2, 0], cos, sin)
        kc = qk_prep(px[9], C_KV, g[2, 1], cos, sin)
        vc = split_heads(px[10], C_KV)
        y_c = dense_block_attention(qc, kc, vc, kc_c, vc_c)
        qd = qk_prep(px[12], D_HEADS, g[3, 0], cos, sin, tail=dtail)
        kd = qk_prep(px[13], D_HEADS, g[3, 1], cos, sin, tail=dtail)
        vd = split_heads(px[14], D_HEADS, (2 * D_HEAD_DIM,))
        y_d = finish_diff(differential_attention(qd, kd, vd, kd_c, vd_c, lam), subln_d[l], lam_init)

        branches_x = [y_a * jax.nn.silu(px[3]), y_b * jax.nn.silu(px[7]),
                      y_c * jax.nn.silu(px[11]), y_d * jax.nn.silu(px[15])]
        x_new = x + gate_x * gated_merge(branches_x, px[16], w_br[l], w_out[l])

        if need_ctx:
            qa_c = qk_prep(pc[0], A_HEADS, g[0, 0])
            ya_c = attend_sets(qa_c.reshape(bsz, ctx_len, A_KV, ga, HEAD_DIM), [(ka_c, va_c)],
                               sink_a[l]).reshape(bsz, ctx_len, -1)
            qb_c = qk_prep(pc[4], B_HEADS, g[1, 0])
            yb_c = attend_sets(qb_c[:, :, :, None], [(kb_c, vb_c)]).reshape(bsz, ctx_len, -1)
            qc_c = qk_prep(pc[8], C_HEADS, g[2, 0])
            yc_c = attend_sets(qc_c.reshape(bsz, ctx_len, C_KV, gc, HEAD_DIM),
                               [(kc_c, vc_c)]).reshape(bsz, ctx_len, -1)
            qd_c = qk_prep(pc[12], D_HEADS, g[3, 0], tail=dtail)
            yd_c = finish_diff(diff_attend_sets(qd_c, [(kd_c, vd_c)], lam), subln_d[l], lam_init)
            branches_c = [ya_c * jax.nn.silu(pc[3]), yb_c * jax.nn.silu(pc[7]),
                          yc_c * jax.nn.silu(pc[11]), yd_c * jax.nn.silu(pc[15])]
            ctx = ctx + gate_c * gated_merge(branches_c, pc[16], w_br[l], w_out[l])
        x = x_new
    return x
```

```cpp
#include <hip/hip_runtime.h>
#include <hip/hip_cooperative_groups.h>
#include <cstdio>
#include <cstdint>
namespace cg = cooperative_groups;
namespace pg8 {
#define PG8_LAS __attribute__((address_space(3)))
typedef unsigned short bf16_t;
typedef short bf16x8 __attribute__((ext_vector_type(8)));
typedef float f32x4 __attribute__((ext_vector_type(4)));
typedef unsigned u32x4 __attribute__((ext_vector_type(4)));
constexpr int BM = 256, BK = 64, HALF = 128, HTB = HALF * BK * 2  , STAGE_BYTES = 8 * HTB, NXCD = 8, WGM = 8;

__host__ __device__ __forceinline__ int lds_byte(int r, int c) { const int st = (r >> 4) * 2 + (c >> 5), rr = r & 15, cc = c & 31, ob = rr * 64 + cc * 2; return st * 1024 + (ob ^ (((ob >> 9) & 1) << 5)); }
__host__ __device__ __forceinline__ void stage_rc(int b, int& R, int& C) { const int st = b / 1024, sb = b % 1024, swz = sb ^ (((sb >> 9) & 1) << 5); R = (st >> 1) * 16 + swz / 64; C = (st & 1) * 32 + (swz % 64) / 2; }
__host__ __device__ __forceinline__ int perm32(int rho) { const int n = rho >> 4, i = rho & 15; return 8 * (i >> 2) + 4 * n + (i & 3); }

struct Unit { int pm, pn; };
struct Gemm { const bf16_t* A; const bf16_t* Bt; int M, N, K; };

struct StaticOrder {
    int nM, nN, nwg, G, c;
    __host__ __device__ void init(int M, int N, int G_, int c_) { nM = M / BM; nN = N / BM; nwg = nM * nN; G = G_; c = c_; }
    __host__ __device__ bool next(int i, Unit& u) const {
        const long L = (long)i * G + c; if (L >= nwg) return false;
        int wgid = (int)L; { const int q = nwg / NXCD, r = nwg % NXCD, xcd = wgid % NXCD, off = wgid / NXCD; wgid = (xcd < r ? xcd * (q + 1) : r * (q + 1) + (xcd - r) * q) + off; }
        const int nig = WGM * nN, gid = wgid / nig, fm = gid * WGM, gsz = (nM - fm) < WGM ? (nM - fm) : WGM;
        u.pm = fm + ((wgid % nig) % gsz); u.pn = (wgid % nig) / gsz; return true;
    }
    __device__ __forceinline__ void a_ready(const Unit&) const {}
    __device__ __forceinline__ void done(const Unit&) const {}
};

__device__ __forceinline__ unsigned cvt_pk_bf16(float lo, float hi) { unsigned r; asm volatile("v_cvt_pk_bf16_f32 %0, %1, %2" : "=v"(r) : "v"(lo), "v"(hi)); return r; }
template <class Epi, class Sched, bool ALIGN_EPI = false, bool SP2 = false, int KC = 0>
__device__ __forceinline__ void gemm_phase(PG8_LAS unsigned char* lds, const Gemm g, const Sched& S, const Epi& E, int tid_in) {
    int tid_op = tid_in; asm volatile("" : "+v"(tid_op));
    const int tid = tid_op, wid = __builtin_amdgcn_readfirstlane(tid >> 6), lane = tid & 63, wr = wid >> 2, wc = wid & 3, fr = lane & 15, fq = lane >> 4;
    const int K = KC ? KC : g.K, nt = K / BK;
    unsigned voffA[2], voffB[2];
#pragma unroll
    for (int i = 0; i < 2; ++i) { int R, C; stage_rc(tid * 16 + i * 8192, R, C); const int Rb = Epi::PERM ? ((R & ~31) + perm32(R & 31)) : R;
        voffA[i] = (unsigned)(R * K + C) * 2u; voffB[i] = (unsigned)(Rb * K + C) * 2u; }
    const size_t kstep = (size_t)(BK * 2);
    const size_t hstep = (size_t)HALF * K * 2;
    const size_t tstep = 2 * hstep;
    const unsigned ldsw = (unsigned)wid * 1024u;
    const int aoff = lds_byte(wr * 64 + fr, fq * 8), boff = lds_byte(wc * 32 + fr, fq * 8);
#define PG8_SA(b, h) (((b) * 2 + (h)) * HTB)
#define PG8_SB(b, h) ((4 + (b) * 2 + (h)) * HTB)
#define PG8_STAGE(bufoff, gbase, voff) do { _Pragma("unroll") for (int _i = 0; _i < 2; ++_i) \
        __builtin_amdgcn_global_load_lds((const unsigned*)((const char*)(gbase) + (voff)[_i]), (PG8_LAS unsigned*)(lds + (bufoff) + ldsw + _i * 8192), 16, 0, 0); } while (0)
#define PG8_LDA(dst, b, h) do { _Pragma("unroll") for (int m = 0; m < 4; ++m) _Pragma("unroll") for (int k = 0; k < 2; ++k) dst[m][k] = *(const PG8_LAS bf16x8*)(lds + PG8_SA(b, h) + aoff + m * 2048 + k * 1024); } while (0)
#define PG8_LDB(dst, b, h) do { _Pragma("unroll") for (int n = 0; n < 2; ++n) _Pragma("unroll") for (int k = 0; k < 2; ++k) dst[n][k] = *(const PG8_LAS bf16x8*)(lds + PG8_SB(b, h) + boff + n * 2048 + k * 1024); } while (0)
#define PG8_MMA(ai, bj, At, Bt) do { __builtin_amdgcn_s_setprio(1); _Pragma("unroll") for (int m = 0; m < 4; ++m) _Pragma("unroll") for (int n = 0; n < 2; ++n) _Pragma("unroll") for (int k = 0; k < 2; ++k) \
        acc[ai][bj][m][n] = __builtin_amdgcn_mfma_f32_16x16x32_bf16(Bt[n][k], At[m][k], acc[ai][bj][m][n], 0, 0, 0); __builtin_amdgcn_s_setprio(0); } while (0)
#define PG8_WAIT_V(n) asm volatile("s_waitcnt vmcnt(" #n ")" ::: "memory")
#define PG8_WAIT_L(n) asm volatile("s_waitcnt lgkmcnt(" #n ")" ::: "memory")
#define PG8_BAR __builtin_amdgcn_s_barrier()
#define PG8_SCHED __builtin_amdgcn_sched_barrier(0)
    Unit cur, nxt; int ui = 0;
    if (!S.next(0, cur)) return;
    f32x4 acc[2][2][4][2];
#pragma unroll
    for (int a = 0; a < 2; ++a)
#pragma unroll
        for (int b = 0; b < 2; ++b)
#pragma unroll
            for (int m = 0; m < 4; ++m)
#pragma unroll
                for (int n = 0; n < 2; ++n) acc[a][b][m][n] = (f32x4){0.f, 0.f, 0.f, 0.f};
    bf16x8 At[4][2], B0[2][2], B1[2][2];
    const char* cA = (const char*)g.A + (size_t)cur.pm * tstep; const char* cB = (const char*)g.Bt + (size_t)cur.pn * tstep;
    S.a_ready(cur);
    if constexpr (SP2) {
        PG8_STAGE(PG8_SB(0, 0), cB, voffB); PG8_STAGE(PG8_SB(0, 1), cB + hstep, voffB); PG8_STAGE(PG8_SA(0, 0), cA, voffA); PG8_STAGE(PG8_SA(0, 1), cA + hstep, voffA);
        if (wr == 1) PG8_BAR;
        PG8_WAIT_V(2); PG8_BAR;
        PG8_STAGE(PG8_SB(1, 0), cB + kstep, voffB); PG8_STAGE(PG8_SA(1, 0), cA + kstep, voffA); PG8_STAGE(PG8_SB(1, 1), cB + hstep + kstep, voffB);
        PG8_WAIT_V(6); PG8_BAR;
    } else {
        PG8_STAGE(PG8_SB(0, 0), cB, voffB); PG8_STAGE(PG8_SA(0, 0), cA, voffA); PG8_STAGE(PG8_SB(0, 1), cB + hstep, voffB); PG8_STAGE(PG8_SA(0, 1), cA + hstep, voffA);
        if (wr == 1) PG8_BAR;
        PG8_WAIT_V(4); PG8_BAR;
        PG8_STAGE(PG8_SB(1, 0), cB + kstep, voffB); PG8_STAGE(PG8_SA(1, 0), cA + kstep, voffA); PG8_STAGE(PG8_SB(1, 1), cB + hstep + kstep, voffB);
        PG8_WAIT_V(6); PG8_BAR;
    }
    for (;;) {
        const bool has_next = S.next(ui + 1, nxt);
        const char* nA = has_next ? (const char*)g.A + (size_t)nxt.pm * tstep : cA; const char* nB = has_next ? (const char*)g.Bt + (size_t)nxt.pn * tstep : cB;
        for (int t = 0; t < nt; t += 2) {
            const bool last = (t == nt - 2);
            const char* a1 = cA + (size_t)(t + 1) * kstep;
            const char* a2 = last ? nA : cA + (size_t)(t + 2) * kstep; const char* b2 = last ? nB : cB + (size_t)(t + 2) * kstep;
            const char* a3 = a2 + kstep; const char* b3 = b2 + kstep;
            if (last && has_next) S.a_ready(nxt);
            if constexpr (SP2) {
            PG8_LDB(B0, 0, 0); PG8_LDB(B1, 0, 1); PG8_SCHED; PG8_LDA(At, 0, 0); PG8_STAGE(PG8_SA(1, 1), a1 + hstep, voffA);
            PG8_WAIT_V(8); PG8_WAIT_L(0); PG8_BAR; PG8_MMA(0, 0, At, B0); PG8_MMA(0, 1, At, B1); PG8_BAR; PG8_SCHED;
            PG8_LDA(At, 0, 1); PG8_STAGE(PG8_SB(0, 0), b2, voffB); PG8_STAGE(PG8_SB(0, 1), b2 + hstep, voffB); PG8_STAGE(PG8_SA(0, 0), a2, voffA);
            PG8_WAIT_V(8); PG8_WAIT_L(0); PG8_BAR; PG8_MMA(1, 0, At, B0); PG8_MMA(1, 1, At, B1); PG8_BAR; PG8_SCHED;
            PG8_LDB(B0, 1, 0); PG8_LDB(B1, 1, 1); PG8_SCHED; PG8_LDA(At, 1, 0); PG8_STAGE(PG8_SA(0, 1), a2 + hstep, voffA);
            PG8_WAIT_V(8); PG8_WAIT_L(0); PG8_BAR; PG8_MMA(0, 0, At, B0); PG8_MMA(0, 1, At, B1); PG8_BAR; PG8_SCHED;
            PG8_LDA(At, 1, 1); PG8_STAGE(PG8_SB(1, 0), b3, voffB); PG8_STAGE(PG8_SB(1, 1), b3 + hstep, voffB); PG8_STAGE(PG8_SA(1, 0), a3, voffA);
            PG8_WAIT_V(8); PG8_WAIT_L(0); PG8_BAR; PG8_MMA(1, 0, At, B0); PG8_MMA(1, 1, At, B1); PG8_BAR; PG8_SCHED;
            } else {
            PG8_LDB(B0, 0, 0); PG8_SCHED; PG8_LDA(At, 0, 0); PG8_STAGE(PG8_SA(1, 1), a1 + hstep, voffA);
            PG8_WAIT_L(8); PG8_BAR; PG8_WAIT_L(0); PG8_MMA(0, 0, At, B0); PG8_BAR; PG8_SCHED;
            PG8_LDB(B1, 0, 1); PG8_STAGE(PG8_SB(0, 0), b2, voffB);
            PG8_BAR; PG8_WAIT_L(0); PG8_MMA(0, 1, At, B1); PG8_BAR;
            PG8_LDA(At, 0, 1); PG8_STAGE(PG8_SA(0, 0), a2, voffA);
            PG8_BAR; PG8_WAIT_L(0); PG8_MMA(1, 0, At, B0); PG8_BAR; PG8_SCHED;
            PG8_STAGE(PG8_SB(0, 1), b2 + hstep, voffB);
            PG8_WAIT_V(6); PG8_BAR; PG8_MMA(1, 1, At, B1); PG8_BAR;
            PG8_LDB(B0, 1, 0); PG8_SCHED; PG8_LDA(At, 1, 0); PG8_STAGE(PG8_SA(0, 1), a2 + hstep, voffA);
            PG8_WAIT_L(8); PG8_BAR; PG8_WAIT_L(0); PG8_MMA(0, 0, At, B0); PG8_BAR; PG8_SCHED;
            PG8_LDB(B1, 1, 1); PG8_STAGE(PG8_SB(1, 0), b3, voffB);
            PG8_BAR; PG8_WAIT_L(0); PG8_MMA(0, 1, At, B1); PG8_BAR;
            PG8_LDA(At, 1, 1); PG8_STAGE(PG8_SA(1, 0), a3, voffA);
            PG8_BAR; PG8_WAIT_L(0); PG8_MMA(1, 0, At, B0); PG8_BAR; PG8_SCHED;
            PG8_STAGE(PG8_SB(1, 1), b3 + hstep, voffB);
            PG8_WAIT_V(6); PG8_BAR; PG8_MMA(1, 1, At, B1); PG8_BAR;
            }
        }
        if constexpr (ALIGN_EPI) { if (wr == 0) PG8_BAR; }
        if constexpr (!Epi::AFTER_DRAIN) { E(acc, cur, wr, wc, fr, fq); S.done(cur); }
        if (!has_next) break;
#pragma unroll
        for (int a = 0; a < 2; ++a)
#pragma unroll
            for (int b = 0; b < 2; ++b)
#pragma unroll
                for (int m = 0; m < 4; ++m)
#pragma unroll
                    for (int n = 0; n < 2; ++n) acc[a][b][m][n] = (f32x4){0.f, 0.f, 0.f, 0.f};
        cur = nxt; cA = nA; cB = nB; ++ui;
        if constexpr (ALIGN_EPI) { if (wr == 1) PG8_BAR; }
    }
    PG8_WAIT_V(0);
    if constexpr (!ALIGN_EPI) { if (wr == 0) PG8_BAR; }
    PG8_BAR;
    if constexpr (Epi::AFTER_DRAIN) { E.fused(acc, cur, wr, wc, fr, fq, lds, wid, lane); S.done(cur); }
#undef PG8_SA
#undef PG8_SB
#undef PG8_STAGE
#undef PG8_LDA
#undef PG8_LDB
#undef PG8_MMA
#undef PG8_WAIT_V
#undef PG8_WAIT_L
#undef PG8_BAR
#undef PG8_SCHED
}
}
using pg8::bf16_t; using pg8::bf16x8; using pg8::f32x4; using pg8::u32x4;
#define LAS __attribute__((address_space(3)))
#define DI __device__ __forceinline__
typedef short s16x4 __attribute__((ext_vector_type(4)));
typedef float f32x16 __attribute__((ext_vector_type(16)));
typedef float f32x2_t __attribute__((ext_vector_type(2)));
typedef __bf16 bf16x2_t __attribute__((ext_vector_type(2)));
typedef unsigned u32x2 __attribute__((ext_vector_type(2)));

constexpr int DM = 1024, SEQ = 8192, NBATCH = 2, CTXL = 256;
constexpr int MX = NBATCH * SEQ, MT = MX + NBATCH * CTXL;
constexpr int NQK = 3328, NV = 1280, NINC = 10752;
constexpr int R_PG = 3328, R_G = 5376, R_V = 9472;
constexpr float LOG2E = 1.4426950408889634f, QSCALE = 0.125f * LOG2E, EPSN = 1e-6f;
constexpr int NTHREADS = 512, NWAVES = 8, LDS_BYTES = 131072 + 256, LDS_MISC = 131072;

constexpr size_t MiB = 1u << 20;
constexpr size_t WS_MOD = 0;
constexpr size_t WS_ROPE = 128 * 1024;
constexpr size_t WS_LAM = 256 * 1024;
constexpr size_t WS_BAR = 512 * 1024;
constexpr size_t WS_CTX1 = 1 * MiB;
constexpr size_t WS_WIN = 4 * MiB;
constexpr size_t WS_WBR = 46 * MiB;
constexpr size_t WS_WOUT = 54 * MiB;
constexpr size_t WS_H = 58 * MiB;
constexpr size_t WS_Y = 91 * MiB;
constexpr size_t WS_PQK = 157 * MiB;
constexpr size_t WS_VT = WS_PQK + (size_t)MT * NQK * 2;
constexpr size_t WS_G = WS_PQK;
constexpr size_t WS_END = WS_VT + (size_t)NV * MT * 2;
static_assert(WS_WIN + (size_t)2 * NINC * DM * 2 <= WS_WBR && WS_H + (size_t)MT * DM * 2 <= WS_Y && WS_Y + (size_t)4 * MT * 512 * 2 <= WS_PQK && WS_G + (size_t)MT * 4096 * 2 <= WS_END, "d_ws map");

struct Params {
    const float *x, *c, *ctx, *c_ctx, *norm_w, *w_ada, *b_ada, *w_in, *qk_gain, *sink_a, *rpb_b, *lam_d, *subln_d, *w_br, *w_out;
    float* out; unsigned char* ws; int ph_lo, ph_hi;
};

DI unsigned cvtpk(float lo, float hi) { f32x2_t v = {lo, hi}; bf16x2_t b = __builtin_convertvector(v, bf16x2_t); return __builtin_bit_cast(unsigned, b); }
DI float bflo(unsigned u) { return __uint_as_float(u << 16); }
DI float bfhi(unsigned u) { return __uint_as_float(u & 0xffff0000u); }
DI float wave_sum(float v) {
#pragma unroll
    for (int o = 1; o < 64; o <<= 1) v += __shfl_xor(v, o);
    return v;
}
DI float fexp2(float x) { return __builtin_amdgcn_exp2f(x); }
DI float silu_f(float x) { return x * __builtin_amdgcn_rcpf(1.f + fexp2(-x * LOG2E)); }
DI float sigm_f(float x) { return __builtin_amdgcn_rcpf(1.f + fexp2(-x * LOG2E)); }

struct EpiAct {
    static constexpr bool PERM = true, AFTER_DRAIN = false;
    int mode, ldc, act; bf16_t* O; bf16_t* Y; bf16_t* VT; int offa, offb;
    DI void operator()(const f32x4 (&acc)[2][2][4][2], const pg8::Unit& u, int wr, int wc, int fr, int fq) const {
        int row0 = u.pm * 256 + wr * 64 + fr;
        bf16_t* base = O; int ld = ldc, colt = u.pn * 256, a = act;
        if (mode == 0) { a = 0; if (u.pn < 13) { ld = NQK; } else if (u.pn < 21) { const int g = u.pn - 13; base = Y + (size_t)(g >> 1) * MT * 512; ld = 512; colt = (g & 1) * 256; a = 1; }
            else { base = VT; ld = MT; colt = (u.pn - offb) * 256; row0 = (u.pm - offa) * 256 + wr * 64 + fr; } }
        const int col0 = colt + wc * 32 + 8 * fq;
#pragma unroll
        for (int ai = 0; ai < 2; ++ai)
#pragma unroll
            for (int m = 0; m < 4; ++m) { bf16_t* rowp = base + (size_t)(row0 + ai * 128 + m * 16) * ld + col0;
#pragma unroll
                for (int bj = 0; bj < 2; ++bj) { f32x4 v0 = acc[ai][bj][m][0], v1 = acc[ai][bj][m][1];
                    if (a == 1) {
#pragma unroll
                        for (int e = 0; e < 4; ++e) { v0[e] = silu_f(v0[e]); v1[e] = silu_f(v1[e]); } }
                    else if (a == 2) {
#pragma unroll
                        for (int e = 0; e < 4; ++e) { v0[e] = sigm_f(v0[e]); v1[e] = sigm_f(v1[e]); } }
                    u32x4 w; w.x = cvtpk(v0[0], v0[1]); w.y = cvtpk(v0[2], v0[3]); w.z = cvtpk(v1[0], v1[1]); w.w = cvtpk(v1[2], v1[3]);
                    *(u32x4*)(rowp + bj * 128) = w; } }
    }
};
struct EpiMerge {
    static constexpr bool PERM = true, AFTER_DRAIN = false;
    bf16_t* O; const bf16_t* G0;
    DI void operator()(const f32x4 (&acc)[2][2][4][2], const pg8::Unit& u, int wr, int wc, int fr, int fq) const {
        const int nbr = u.pn >> 2; const bool first = (nbr == 0); const bf16_t* G = G0 + nbr * 1024;
        const int row0 = (u.pm - 66 * nbr) * 256 + wr * 64 + fr;
        const int col0 = (u.pn & 3) * 256 + wc * 32 + 8 * fq;
#pragma unroll
        for (int ai = 0; ai < 2; ++ai) {
            u32x4 g[4][2], o[4][2];
#pragma unroll
            for (int m = 0; m < 4; ++m)
#pragma unroll
                for (int bj = 0; bj < 2; ++bj) { const size_t row = (size_t)(row0 + ai * 128 + m * 16); const int col = col0 + bj * 128;
                    g[m][bj] = *(const u32x4*)(G + row * 4096 + col);
                    if (!first) o[m][bj] = *(const u32x4*)(O + row * 1024 + col); else o[m][bj] = (u32x4){0u, 0u, 0u, 0u}; }
#pragma unroll
            for (int m = 0; m < 4; ++m)
#pragma unroll
                for (int bj = 0; bj < 2; ++bj) { const size_t row = (size_t)(row0 + ai * 128 + m * 16); const int col = col0 + bj * 128;
                    const u32x4 gg = g[m][bj], oo = o[m][bj];
                    f32x4 v0 = acc[ai][bj][m][0], v1 = acc[ai][bj][m][1];
                    v0[0] = v0[0] * bflo(gg.x) + bflo(oo.x); v0[1] = v0[1] * bfhi(gg.x) + bfhi(oo.x); v0[2] = v0[2] * bflo(gg.y) + bflo(oo.y); v0[3] = v0[3] * bfhi(gg.y) + bfhi(oo.y);
                    v1[0] = v1[0] * bflo(gg.z) + bflo(oo.z); v1[1] = v1[1] * bfhi(gg.z) + bfhi(oo.z); v1[2] = v1[2] * bflo(gg.w) + bflo(oo.w); v1[3] = v1[3] * bfhi(gg.w) + bfhi(oo.w);
                    u32x4 w; w.x = cvtpk(v0[0], v0[1]); w.y = cvtpk(v0[2], v0[3]); w.z = cvtpk(v1[0], v1[1]); w.w = cvtpk(v1[2], v1[3]);
                    *(u32x4*)(O + row * 1024 + col) = w; }
            asm volatile("" ::: "memory");
        }
    }
};
struct EpiOut {
    static constexpr bool PERM = true, AFTER_DRAIN = false;
    const float* xres; float* xout; const float* cres; float* cout; const float* modl;
    DI void operator()(const f32x4 (&acc)[2][2][4][2], const pg8::Unit& u, int wr, int wc, int fr, int fq) const {
        const int row0 = u.pm * 256 + wr * 64 + fr;
        const float* res; float* out; const float* gate; int rbase;
        if (u.pm < 64) { res = xres; out = xout; gate = modl + (u.pm >> 5) * 3072 + 2048; rbase = row0; }
        else { res = cres; out = cout; gate = modl + 2 * 3072 + 2048; rbase = row0 - MX; }
        const int col0 = u.pn * 256 + wc * 32 + 8 * fq;
#pragma unroll
        for (int bj = 0; bj < 2; ++bj)
#pragma unroll
            for (int n = 0; n < 2; ++n) { const int col = col0 + bj * 128 + 4 * n; const f32x4 gv = *(const f32x4*)(gate + col);
                f32x4 rv[2][4];
#pragma unroll
                for (int ai = 0; ai < 2; ++ai)
#pragma unroll
                    for (int m = 0; m < 4; ++m) rv[ai][m] = *(const f32x4*)(res + (size_t)(rbase + ai * 128 + m * 16) * 1024 + col);
#pragma unroll
                for (int ai = 0; ai < 2; ++ai)
#pragma unroll
                    for (int m = 0; m < 4; ++m) *(f32x4*)(out + (size_t)(rbase + ai * 128 + m * 16) * 1024 + col) = rv[ai][m] + gv * acc[ai][bj][m][n];
                asm volatile("" ::: "memory"); }
    }
};

struct PackedOrder {
    unsigned long long w0, w1, w2; int n;
    DI void init(int M, int N, int G, int c) {
        pg8::StaticOrder S; S.init(M, N, G, c); w0 = 0ull; w1 = 0ull; w2 = 0ull; n = 0;
#pragma unroll
        for (int i = 0; i < 12; ++i) { pg8::Unit u; const bool ok = S.next(i, u);
            if (ok) { const unsigned long long v = (unsigned long long)((u.pm << 8) | u.pn) << (16 * (i & 3)); if (i < 4) w0 |= v; else if (i < 8) w1 |= v; else w2 |= v; n = i + 1; } }
        w0 = __builtin_amdgcn_readfirstlane((unsigned)w0) | ((unsigned long long)__builtin_amdgcn_readfirstlane((unsigned)(w0 >> 32)) << 32);
        w1 = __builtin_amdgcn_readfirstlane((unsigned)w1) | ((unsigned long long)__builtin_amdgcn_readfirstlane((unsigned)(w1 >> 32)) << 32);
        w2 = __builtin_amdgcn_readfirstlane((unsigned)w2) | ((unsigned long long)__builtin_amdgcn_readfirstlane((unsigned)(w2 >> 32)) << 32);
        n = __builtin_amdgcn_readfirstlane(n);
    }
    DI bool next(int i, pg8::Unit& u) const {
        if (i >= n) return false;
        const unsigned long long x = (i < 4) ? w0 : (i < 8) ? w1 : w2; const unsigned v = (unsigned)(x >> (16 * (i & 3))) & 0xffffu;
        u.pm = (int)(v >> 8); u.pn = (int)(v & 255u); return true;
    }
    DI void a_ready(const pg8::Unit&) const {}
    DI void done(const pg8::Unit&) const {}
};

struct InProjOrder {
    pg8::StaticOrder S0; int G, c, offa, offb;
    DI void init(int G_, int c_, int layer) { S0.init(MT, R_G, G_, c_); G = G_; c = c_; offa = -71 + 42 * layer; offb = 108 - 42 * layer; }
    DI bool next(int i, pg8::Unit& u) const {
        if (S0.next(i, u)) return true;
        const int Lv = i * G + c - 66 * 21; if (Lv >= 5 * 66) return false;
        u.pm = Lv % 5 + offa; u.pn = Lv / 5 + offb; return true;
    }
    DI void a_ready(const pg8::Unit&) const {}
    DI void done(const pg8::Unit&) const {}
};
static_assert((WS_WIN + (size_t)R_V * DM * 2) % (256 * 1024 * 2) == (WS_H % (256 * 1024 * 2)) && ((size_t)NINC * DM * 2) % (256 * 1024 * 2) == 0, "tile-offset trick of InProjOrder");

struct MergeOrder {
    pg8::StaticOrder S0;
    DI void init(int M, int G_, int c_) { S0.init(M, DM, G_, c_); }
    DI bool next(int i, pg8::Unit& u) const { if (!S0.next(i >> 2, u)) return false; const int n = i & 3; u.pm += 66 * n; u.pn += 4 * n; return true; }
    DI void a_ready(const pg8::Unit&) const {}
    DI void done(const pg8::Unit&) const {}
};
static_assert(((size_t)MT * 512 * 2) == (size_t)66 * 256 * 512 * 2 && ((size_t)1024 * 512 * 2) == (size_t)4 * 256 * 512 * 2, "tile-offset trick of MergeOrder");

DI int win_dest_row(int n) {
    if (n >= 6656) return R_G + (n - 6656);
    const int mix = (n >= 4608) ? 3 : (n >= 3328) ? 2 : (n >= 1280) ? 1 : 0;
    const int mstart = (mix == 3) ? 4608 : (mix == 2) ? 3328 : (mix == 1) ? 1280 : 0;
    const int o = n - mstart;
    const bool wide = (mix & 1);
    const int kw = wide ? 512 : 128;
    const int qk0 = (mix == 0) ? 0 : (mix == 1) ? 640 : (mix == 2) ? 1664 : 2304;
    const int v0 = (mix == 0) ? 0 : (mix == 1) ? 128 : (mix == 2) ? 640 : 768;
    if (o < 512 + kw) return qk0 + o;
    if (o < 512 + 2 * kw) return R_V + v0 + (o - 512 - kw);
    return R_PG + mix * 512 + (o - 512 - 2 * kw);
}
DI void transpose_item(const float* W, int K, int N, bf16_t* WT, int drow0, LAS float* scr, int k0, int n0, int lane) {
#pragma unroll 8
    for (int i = 0; i < 32; ++i) { const int kk = 2 * i + (lane >> 5); scr[kk * 33 + (lane & 31)] = W[(size_t)(k0 + kk) * N + n0 + (lane & 31)]; }
    asm volatile("s_waitcnt lgkmcnt(0)" ::: "memory");
    const int c = lane & 7;
#pragma unroll
    for (int j = 0; j < 4; ++j) { const int n = (lane >> 3) + 8 * j; const LAS float* s = scr + (8 * c) * 33 + n;
        u32x4 o; o.x = cvtpk(s[0 * 33], s[1 * 33]); o.y = cvtpk(s[2 * 33], s[3 * 33]); o.z = cvtpk(s[4 * 33], s[5 * 33]); o.w = cvtpk(s[6 * 33], s[7 * 33]);
        *(u32x4*)(WT + (size_t)(drow0 + n) * K + k0 + 8 * c) = o; }
    asm volatile("s_waitcnt lgkmcnt(0)" ::: "memory");
}

DI void weight_copies(const Params& P, LAS unsigned char* lds, int l, int gw, int ngw, int wave, int lane) {
    unsigned char* ws = P.ws;
    LAS float* scr = (LAS float*)(lds + 20480 + wave * 8448);
    constexpr int I_IN = 16 * (NINC / 32), I_BR = 8 * 32, I_OUT = 16 * 32, I_L = I_IN + 4 * I_BR + I_OUT;
    for (int it = gw; it < I_L; it += ngw) {
        int rI = it;
        if (rI < I_IN) { const int kb = rI / (NINC / 32), nb = rI % (NINC / 32), n0 = nb * 32;
            transpose_item(P.w_in + (size_t)l * DM * NINC, DM, NINC, (bf16_t*)(ws + WS_WIN) + (size_t)l * NINC * DM, win_dest_row(n0), scr, kb * 64, n0, lane); continue; }
        rI -= I_IN;
        if (rI < 4 * I_BR) { const int n = rI / I_BR, q = rI % I_BR, kb = q / 32, nb = q % 32;
            transpose_item(P.w_br + (size_t)(l * 4 + n) * 512 * 1024, 512, 1024, (bf16_t*)(ws + WS_WBR) + (size_t)(l * 4 + n) * 1024 * 512, nb * 32, scr, kb * 64, nb * 32, lane); continue; }
        rI -= 4 * I_BR;
        { const int kb = rI / 32, nb = rI % 32;
            transpose_item(P.w_out + (size_t)l * DM * DM, DM, DM, (bf16_t*)(ws + WS_WOUT) + (size_t)l * DM * DM, nb * 32, scr, kb * 64, nb * 32, lane); }
    }
}

DI void prologue_phase(const Params& P, LAS unsigned char* lds, int bid, int G, int tid, int lane, int wave) {
    unsigned char* ws = P.ws;
    if (bid < 192) {
        LAS float* sv = (LAS float*)lds;
        LAS float* red = (LAS float*)(lds + 12288);
        for (int i = tid; i < 3072; i += NTHREADS) { const int v = i >> 10, k = i & 1023; const float a = (v < 2) ? P.c[v * 1024 + k] : P.c_ctx[k]; sv[i] = silu_f(a); }
        __syncthreads();
        const int kc = tid >> 5, cl = tid & 31, j = bid * 32 + cl, l = j / 3072, jj = j % 3072;
        const float* wp = P.w_ada + (size_t)l * 1024 * 3072 + jj;
        float a0 = 0.f, a1 = 0.f, a2 = 0.f;
#pragma unroll 8
        for (int k = kc * 64; k < kc * 64 + 64; ++k) { const float w = wp[(size_t)k * 3072]; a0 += sv[k] * w; a1 += sv[1024 + k] * w; a2 += sv[2048 + k] * w; }
        red[(kc * 32 + cl) * 3 + 0] = a0; red[(kc * 32 + cl) * 3 + 1] = a1; red[(kc * 32 + cl) * 3 + 2] = a2;
        __syncthreads();
        if (tid < 96) { const int c2 = tid & 31, v = tid >> 5; float s = 0.f;
#pragma unroll
            for (int q = 0; q < 16; ++q) s += red[(q * 32 + c2) * 3 + v];
            const int j2 = bid * 32 + c2, l2 = j2 / 3072, jj2 = j2 % 3072;
            ((float*)(ws + WS_MOD))[(l2 * 3 + v) * 3072 + jj2] = s + P.b_ada[l2 * 3072 + jj2]; }
        __syncthreads();
    } else if (bid == 192) {
        for (int e = tid; e < 2048; e += NTHREADS) { const int pos = e >> 4, i = e & 15;
            const float fr = __builtin_amdgcn_exp2f(-(float)i * (13.287712379549449f / 16.f));
            const float ang = (float)pos * fr; double rev = (double)ang * 0.15915494309189535; rev -= __builtin_rint(rev);
            f32x2_t cs; cs.x = __builtin_amdgcn_cosf((float)rev); cs.y = __builtin_amdgcn_sinf((float)rev);
            ((f32x2_t*)(ws + WS_ROPE))[e] = cs; }
    } else if (bid == 193) {
        if (tid < 2) { const float* lf = P.lam_d + tid * 256; float s1 = 0.f, s2 = 0.f;
            for (int d = 0; d < 64; ++d) { s1 += lf[d] * lf[64 + d]; s2 += lf[128 + d] * lf[192 + d]; }
            const float lam_init = (tid == 0) ? 0.2f : 0.35550906759f;
            ((float*)(ws + WS_LAM))[tid] = fexp2(s1 * LOG2E) - fexp2(s2 * LOG2E) + lam_init; }
        if (tid >= 64 && tid < 72) { const int l = (tid - 64) >> 2, mx = (tid - 64) & 3; const float* gq = P.qk_gain + l * 512 + mx * 128; float a = 0.f, c = 0.f;
            for (int d = 0; d < 64; ++d) { a = fmaxf(a, fabsf(gq[d])); c = fmaxf(c, fabsf(gq[64 + d])); }
            ((float*)(ws + WS_LAM))[4 + l * 4 + mx] = 64.0f * a * c * QSCALE * 1.02f; }
    }
    weight_copies(P, lds, 0, bid * NWAVES + wave, G * NWAVES, wave, lane);
}

DI void norm_phase(const float* xsrc, const float* csrc, const float* nw, const float* modl, bf16_t* H, int gw, int NGW, int lane) {
    for (int row = gw; row < MT; row += NGW) {
        const float* src; const float* mv;
        if (row < MX) { src = xsrc + (size_t)row * DM; mv = modl + (row >> 13) * 3072; } else { src = csrc + (size_t)(row - MX) * DM; mv = modl + 2 * 3072; }
        f32x4 v[4]; float ss = 0.f;
#pragma unroll
        for (int j = 0; j < 4; ++j) { v[j] = ((const f32x4*)src)[lane + 64 * j]; ss += (v[j].x * v[j].x + v[j].y * v[j].y) + (v[j].z * v[j].z + v[j].w * v[j].w); }
        const float rn = 1.0f / sqrtf(wave_sum(ss) * (1.f / DM) + EPSN);
#pragma unroll
        for (int j = 0; j < 4; ++j) { const int col = 4 * lane + 256 * j;
            const f32x4 w = *(const f32x4*)(nw + col), sh = *(const f32x4*)(mv + col), sc = *(const f32x4*)(mv + 1024 + col);
            const f32x4 y = (v[j] * rn) * w * (sc + 1.0f) + sh;
            u32x2 o; o.x = cvtpk(y.x, y.y); o.y = cvtpk(y.z, y.w);
            *(u32x2*)(H + (size_t)row * DM + col) = o; }
    }
}

DI void prep_item(bf16_t* p, u32x2 raw, int row, int hh, int l16, const float* gain_l, const f32x2_t* rope, bool dry) {
    int mixer, isk;
    if (hh < 8) { mixer = 0; isk = 0; } else if (hh < 10) { mixer = 0; isk = 1; } else if (hh < 18) { mixer = 1; isk = 0; } else if (hh < 26) { mixer = 1; isk = 1; }
    else if (hh < 34) { mixer = 2; isk = 0; } else if (hh < 36) { mixer = 2; isk = 1; } else if (hh < 44) { mixer = 3; isk = 0; } else { mixer = 3; isk = 1; }
    float y0 = bflo(raw.x), y1 = bfhi(raw.x), y2 = bflo(raw.y), y3 = bfhi(raw.y);
    float ss = (y0 * y0 + y1 * y1) + (y2 * y2 + y3 * y3);
    ss += __shfl_xor(ss, 1); ss += __shfl_xor(ss, 2); ss += __shfl_xor(ss, 4); ss += __shfl_xor(ss, 8);
    const float rn = 1.0f / sqrtf(ss * (1.f / 64.f) + EPSN);
    const f32x4 g = *(const f32x4*)(gain_l + (mixer * 2 + isk) * 64 + l16 * 4);
    y0 = y0 * rn * g.x; y1 = y1 * rn * g.y; y2 = y2 * rn * g.z; y3 = y3 * rn * g.w;
    const float p0 = __shfl_xor(y0, 4), p1 = __shfl_xor(y1, 4), p2 = __shfl_xor(y2, 4), p3 = __shfl_xor(y3, 4);
    if (mixer != 1 && row < MX) {
        const int t = row & (SEQ - 1), pos = (l16 < 8) ? (t >> 6) : (t & 63);
        const f32x2_t* rp = rope + pos * 16 + (l16 & 3) * 4;
        const f32x2_t c0 = rp[0], c1 = rp[1], c2 = rp[2], c3 = rp[3];
        const float sg = (l16 & 4) ? 1.f : -1.f;
        y0 = y0 * c0.x + sg * p0 * c0.y; y1 = y1 * c1.x + sg * p1 * c1.y; y2 = y2 * c2.x + sg * p2 * c2.y; y3 = y3 * c3.x + sg * p3 * c3.y;
    }
    if (!isk) { y0 *= QSCALE; y1 *= QSCALE; y2 *= QSCALE; y3 *= QSCALE; }
    u32x2 o; o.x = cvtpk(y0, y1); o.y = cvtpk(y2, y3);
    if (!dry) *(u32x2*)p = o;
}
DI void prep_phase(bf16_t* Pqk, const float* gain_l, const f32x2_t* rope, int gw, int NGW, int lane, bool dry) {
    const int sub = lane >> 4, l16 = lane & 15;
    constexpr int NIT = MT * 20 / 4;
    for (int it0 = gw * 4; it0 < NIT; it0 += NGW * 4) {
        bf16_t* p[4]; u32x2 raw[4]; int row[4], hh[4];
#pragma unroll
        for (int u = 0; u < 4; ++u) { const int it = min(it0 + u, NIT - 1); const int item = it * 4 + sub; row[u] = item / 20; const int kq = item % 20;
            hh[u] = (kq < 2) ? 8 + kq : (kq < 10) ? 16 + kq : (kq < 12) ? 24 + kq : 32 + kq;
            p[u] = Pqk + (size_t)row[u] * NQK + hh[u] * 64 + l16 * 4; raw[u] = *(const u32x2*)p[u]; }
#pragma unroll
        for (int u = 0; u < 4; ++u) if (it0 + u < NIT) prep_item(p[u], raw[u], row[u], hh[u], l16, gain_l, rope, dry);
    }
}

constexpr int KROW = 144, VROW = 144, KBUF = 64 * KROW, VBUF = 128 * VROW, BIAS_OFF = 4 * KBUF + 2 * VBUF, QOFF = BIAS_OFF + 2048;
static_assert(QOFF + 8 * 4096 <= 131072 && BIAS_OFF + 2048 <= LDS_BYTES && 4 * 64 * 64 * 4 <= BIAS_OFF, "attention LDS map");
#define MFMA32(a, b, c) __builtin_amdgcn_mfma_f32_32x32x16_bf16((a), (b), (c), 0, 0, 0)

DI float swapmax(float m) { auto rr = __builtin_amdgcn_permlane32_swap(__float_as_uint(m), __float_as_uint(m), false, false); return fmaxf(__uint_as_float(rr[0]), __uint_as_float(rr[1])); }
DI float swapsum(float m) { auto rr = __builtin_amdgcn_permlane32_swap(__float_as_uint(m), __float_as_uint(m), false, false); return __uint_as_float(rr[0]) + __uint_as_float(rr[1]); }
#define KOFF(bf) ((bf) * 2 * KBUF)
#define VOFF(bf) (4 * KBUF + (bf) * VBUF)
template <int TYPE, bool FASTP>
DI void attn_unit(LAS unsigned char* lds, const bf16_t* __restrict__ Pqk, const bf16_t* __restrict__ Vt, bf16_t* Ymix,
                  int b, int h, int qb, bool isctx, float sink_l2, const float* rpb_h, const float* lamp, int layer_i, const float* subln, bool dry, float mref_fixed, int tid_in, const float* gain_q, const f32x2_t* rope) {
    constexpr int DV = (TYPE == 3) ? 128 : 64, NDB = DV / 32;
    int tid_op = tid_in; asm volatile("" : "+v"(tid_op));
    const int tid = tid_op, lane = tid & 63, r = lane & 31, hi = lane >> 5;
    const int w = __builtin_amdgcn_readfirstlane(tid >> 6);
    const int kset = (TYPE == 3) ? (w >> 2) : 0, wq = (TYPE == 3) ? (w & 3) : w;
    const int qtok = ((TYPE == 3) ? 128 : 256) * qb + 32 * wq;
    const int ctxrow = MX + b * CTXL, latrow = b * SEQ;
    const int qrow0 = isctx ? (ctxrow + qtok) : (latrow + qtok);
    int qcol, kcol, vrow;
    if (TYPE == 0) { qcol = h * 64; kcol = 512 + (h >> 2) * 64; vrow = (h >> 2) * 64; }
    else if (TYPE == 1) { qcol = 640 + h * 64; kcol = 1152 + h * 64; vrow = 128 + h * 64; }
    else if (TYPE == 2) { qcol = 1664 + h * 64; kcol = 2176 + (h >> 2) * 64; vrow = 640 + (h >> 2) * 64; }
    else { qcol = 2304 + (2 * h + kset) * 64; kcol = 2816 + 2 * h * 64; vrow = 768 + h * 128; }
    int tl0 = 0, tl1 = 0;
    if (!isctx) {
        if (TYPE == 0) { tl0 = max(0, 4 * qb - 2); tl1 = min(128, 4 * qb + 6); }
        else if (TYPE == 1) { tl0 = min(max(4 * qb - 4, 0), 120); tl1 = min(max(4 * qb + 3 - 4, 0), 120) + 8; }
        else { tl0 = 0; tl1 = 128; }
    }
    const int NT = 4 + (tl1 - tl0);
    if (TYPE == 1 && !isctx) { if (tid < 465) ((LAS float*)(lds + BIAS_OFF))[tid] = rpb_h[tid] * LOG2E; }
    bf16x8 qr[4];
    { const bf16_t* qp = Pqk + (size_t)(qrow0 + r) * NQK + qcol + hi * 8;
#pragma unroll
        for (int d0 = 0; d0 < 4; ++d0) qr[d0] = *(const bf16x8*)(qp + d0 * 16); }
    { float x[4][8]; float ss = 0.f;
#pragma unroll
        for (int d0 = 0; d0 < 4; ++d0)
#pragma unroll
            for (int e = 0; e < 8; ++e) { x[d0][e] = __uint_as_float(((unsigned)(unsigned short)qr[d0][e]) << 16); ss += x[d0][e] * x[d0][e]; }
        ss = swapsum(ss);
        const float rn = (1.0f / sqrtf(ss * (1.f / 64.f) + EPSN));
#pragma unroll
        for (int d0 = 0; d0 < 4; ++d0) { const f32x4 g0 = *(const f32x4*)(gain_q + d0 * 16 + hi * 8), g1 = *(const f32x4*)(gain_q + d0 * 16 + hi * 8 + 4);
            x[d0][0] *= rn * g0.x; x[d0][1] *= rn * g0.y; x[d0][2] *= rn * g0.z; x[d0][3] *= rn * g0.w; x[d0][4] *= rn * g1.x; x[d0][5] *= rn * g1.y; x[d0][6] *= rn * g1.z; x[d0][7] *= rn * g1.w; }
        if (TYPE != 1 && !isctx) { const int t = qtok + r;
#pragma unroll
            for (int a = 0; a < 2; ++a) { const int pos = a ? (t & 63) : (t >> 6); const f32x2_t* rp = rope + pos * 16 + hi * 8;
#pragma unroll
                for (int e = 0; e < 8; ++e) { const f32x2_t cs = rp[e]; const float y0 = x[2 * a][e], y1 = x[2 * a + 1][e]; x[2 * a][e] = y0 * cs.x - y1 * cs.y; x[2 * a + 1][e] = y1 * cs.x + y0 * cs.y; } } }
#pragma unroll
        for (int d0 = 0; d0 < 4; ++d0) { u32x4 t4; t4.x = cvtpk(x[d0][0] * QSCALE, x[d0][1] * QSCALE); t4.y = cvtpk(x[d0][2] * QSCALE, x[d0][3] * QSCALE); t4.z = cvtpk(x[d0][4] * QSCALE, x[d0][5] * QSCALE); t4.w = cvtpk(x[d0][6] * QSCALE, x[d0][7] * QSCALE);
            qr[d0] = __builtin_bit_cast(bf16x8, t4); } }
    constexpr bool QLDS = (TYPE == 3 && !FASTP);
    LAS unsigned char* qlds = lds + QOFF + w * 4096 + r * 128 + hi * 16;
    if (QLDS) {
#pragma unroll
        for (int d0 = 0; d0 < 4; ++d0) *(LAS bf16x8*)(qlds + d0 * 32) = qr[d0];
    }
#define QFRAG(d0) (QLDS ? *(LAS const bf16x8*)(qlds + (d0) * 32) : qr[d0])
    f32x16 o[NDB];
#pragma unroll
    for (int db = 0; db < NDB; ++db)
#pragma unroll
        for (int i = 0; i < 16; ++i) o[db][i] = 0.f;
    float mref = 0.f, l = 0.f;
    if (TYPE == 0) { mref = sink_l2; l = (hi == 0) ? 1.f : 0.f; }
    const int lrow = tid >> 3, lch = tid & 7;
    u32x4 kA0, kA1, vA0, vA1, kB0, kB1, vB0, vB1;
#define ATT_TB(j) (((j) < 4) ? ctxrow + 64 * (j) : latrow + 64 * (tl0 + (j) - 4))
#define ATT_LOADK(j, K0, K1) do { const bf16_t* kp_ = Pqk + (size_t)(ATT_TB(j) + lrow) * NQK + kcol + lch * 8; K0 = *(const u32x4*)kp_; if (TYPE == 3) K1 = *(const u32x4*)(kp_ + 64); } while (0)
#define ATT_LOADV(j, V0, V1) do { const bf16_t* vp_ = Vt + (size_t)(vrow + lrow) * MT + ATT_TB(j) + lch * 8; V0 = *(const u32x4*)vp_; if (TYPE == 3) V1 = *(const u32x4*)(vp_ + (size_t)64 * MT); } while (0)
#define ATT_STOREK(bf, K0, K1) do { LAS unsigned char* sb_ = lds + KOFF(bf); *(LAS u32x4*)(sb_ + lrow * KROW + lch * 16) = K0; if (TYPE == 3) *(LAS u32x4*)(sb_ + KBUF + lrow * KROW + lch * 16) = K1; } while (0)
#define ATT_STOREV(bf, V0, V1) do { LAS unsigned char* vb_ = lds + VOFF(bf) + lrow * VROW + (lch >> 1) * 32 + (lch & 1) * 8;     \
        *(LAS u32x2*)vb_ = (u32x2){V0.x, V0.y}; *(LAS u32x2*)(vb_ + 16) = (u32x2){V0.z, V0.w}; \
        if (TYPE == 3) { *(LAS u32x2*)(vb_ + 64 * VROW) = (u32x2){V1.x, V1.y}; *(LAS u32x2*)(vb_ + 64 * VROW + 16) = (u32x2){V1.z, V1.w}; } } while (0)
    const float NEG = -__builtin_inff();
    unsigned okmask = 0u;
    if (TYPE == 1) { const int qc = 32 * (wq & 1) + r, cs = min(max(qc - 8, 0), 48);
#pragma unroll
        for (int i = 0; i < 16; ++i) { const int kc = (i & 3) + 8 * (i >> 2) + 4 * hi; if (kc >= cs && kc < cs + 16) okmask |= 1u << i; if (kc + 32 >= cs && kc + 32 < cs + 16) okmask |= 1u << (16 + i); } }
#define SGB(m, n) __builtin_amdgcn_sched_group_barrier((m), (n), 0)
#define ATT_STEP(SC, SN, DOQK, KBF, KHF, VBF, VHF, MK, PA, FAST, PSUM, KF, KN, NKBF, NKHF, DONEXT) do { \
        LAS const unsigned char* Vb_ = lds + VOFF(VBF) + r * VROW + hi * 16 + (VHF) * 64; \
        bf16x8 va_[NDB][2]; bf16x8 ka_, kb_, kc_, kd_; \
        if (NDB == 2) { _Pragma("unroll") for (int db_ = 0; db_ < NDB; ++db_) { va_[db_][0] = *(LAS const bf16x8*)(Vb_ + db_ * 32 * VROW); va_[db_][1] = *(LAS const bf16x8*)(Vb_ + db_ * 32 * VROW + 32); } } \
        if (KPF) { ka_ = KF[0]; kb_ = KF[1]; kc_ = KF[2]; kd_ = KF[3]; \
            if (DONEXT) { LAS const unsigned char* Kn_ = lds + KOFF(NKBF) + kset * KBUF + ((NKHF) * 32 + r) * KROW + hi * 16; \
                KN[0] = *(LAS const bf16x8*)(Kn_); KN[1] = *(LAS const bf16x8*)(Kn_ + 32); KN[2] = *(LAS const bf16x8*)(Kn_ + 64); KN[3] = *(LAS const bf16x8*)(Kn_ + 96); } } \
        else if (DOQK) { LAS const unsigned char* Kb_ = lds + KOFF(KBF) + kset * KBUF + ((KHF) * 32 + r) * KROW + hi * 16; \
            ka_ = *(LAS const bf16x8*)(Kb_); kb_ = *(LAS const bf16x8*)(Kb_ + 32); kc_ = *(LAS const bf16x8*)(Kb_ + 64); kd_ = *(LAS const bf16x8*)(Kb_ + 96); } \
        if (TYPE == 0 && (MK) == 1) { _Pragma("unroll") for (int i_ = 0; i_ < 16; ++i_) { const int d_ = (PA) + 32 * (VHF) + (i_ & 3) + 8 * (i_ >> 2); if (d_ > 128 || d_ < -128) SC[i_] = NEG; } } \
        if (TYPE == 1 && (MK) == 2) { unsigned okm_ = okmask; int dcb_ = 4 * hi - (32 * (wq & 1) + r) + 15 + (PA) + 32 * (VHF); asm volatile("" : "+v"(okm_), "+v"(dcb_)); \
            LAS const float* bl_ = (LAS const float*)(lds + BIAS_OFF) + dcb_; \
            _Pragma("unroll") for (int i_ = 0; i_ < 16; ++i_) { const float bv_ = bl_[(i_ & 3) + 8 * (i_ >> 2)]; SC[i_] = ((okm_ >> (16 * (VHF) + i_)) & 1u) ? SC[i_] + bv_ : NEG; } } \
        f32x16 z_; _Pragma("unroll") for (int i_ = 0; i_ < 16; ++i_) z_[i_] = 0.f; \
        if (DOQK) SN = MFMA32(ka_, QFRAG(0), z_); \
        _Pragma("unroll") for (int i_ = 0; i_ < 8; ++i_) SC[i_] = (FAST) ? fexp2(SC[i_]) : fexp2(SC[i_] - mref); \
        if (DOQK) SN = MFMA32(kb_, QFRAG(1), SN); \
        u32x4 t0_, t1_; t0_.x = cvtpk(SC[0], SC[1]); t0_.y = cvtpk(SC[2], SC[3]); t0_.z = cvtpk(SC[4], SC[5]); t0_.w = cvtpk(SC[6], SC[7]); \
        if (DOQK) SN = MFMA32(kc_, QFRAG(2), SN); \
        _Pragma("unroll") for (int i_ = 8; i_ < 16; ++i_) SC[i_] = (FAST) ? fexp2(SC[i_]) : fexp2(SC[i_] - mref); \
        if (DOQK) SN = MFMA32(kd_, QFRAG(3), SN); \
        t1_.x = cvtpk(SC[8], SC[9]); t1_.y = cvtpk(SC[10], SC[11]); t1_.z = cvtpk(SC[12], SC[13]); t1_.w = cvtpk(SC[14], SC[15]); \
        const bf16x8 pf0_ = __builtin_bit_cast(bf16x8, t0_), pf1_ = __builtin_bit_cast(bf16x8, t1_); \
        float ps_ = PSUM; \
        _Pragma("unroll") for (int db_ = 0; db_ < NDB; ++db_) { \
            if (NDB != 2) { va_[db_][0] = *(LAS const bf16x8*)(Vb_ + db_ * 32 * VROW); va_[db_][1] = *(LAS const bf16x8*)(Vb_ + db_ * 32 * VROW + 32); } \
            o[db_] = MFMA32(va_[db_][0], pf0_, o[db_]); \
            _Pragma("unroll") for (int i_ = 0; i_ < 8 / NDB; ++i_) ps_ += SC[db_ * (8 / NDB) + i_]; \
            o[db_] = MFMA32(va_[db_][1], pf1_, o[db_]); \
            _Pragma("unroll") for (int i_ = 0; i_ < 8 / NDB; ++i_) ps_ += SC[8 + db_ * (8 / NDB) + i_]; } \
        PSUM = ps_; \
        if (TYPE == 2) { SGB(0x100, ((KPF ? (DONEXT) : (DOQK)) ? 4 : 0) + 2 * NDB); \
            if (DOQK) { SGB(0x008, 1); SGB(0x402, (FAST) ? 8 : 16); SGB(0x008, 1); SGB(0x402, 4); SGB(0x008, 1); SGB(0x402, (FAST) ? 8 : 16); SGB(0x008, 1); SGB(0x402, 4); } \
            _Pragma("unroll") for (int db_ = 0; db_ < 2 * NDB; ++db_) { SGB(0x008, 1); SGB(0x402, 8 / NDB); } } } while (0)
#define ATT_RESCALE(PSUM) do { const float c0_ = swapmax(PSUM); \
        if (__any(c0_ > 8192.0f)) { const float c_ = fmaxf(c0_ * (1.0f / 32.0f), 1.0f), sc_ = __builtin_amdgcn_rcpf(c_); mref += __builtin_amdgcn_logf(c_); l *= sc_; \
            _Pragma("unroll") for (int db_ = 0; db_ < NDB; ++db_) o[db_] = o[db_] * sc_; } } while (0)
#define ATT_TILEINFO(j, skip, mk, pa) do { skip = false; mk = 0; pa = 0; if ((j) >= 4) { \
        if (TYPE == 0) { const int kp0_ = 64 * (tl0 + (j) - 4); skip = (kp0_ + 63 < qtok - 128) || (kp0_ > qtok + 31 + 128); mk = 1; pa = kp0_ - (qtok + r) + 4 * hi; } \
        if (TYPE == 1) { const int kr_ = tl0 + (j) - 4, qrw_ = 4 * qb + (wq >> 1), rs_ = min(max(qrw_ - 4, 0), 120); skip = (kr_ < rs_) || (kr_ >= rs_ + 8); mk = 2; pa = (kr_ - qrw_ + 7) * 31; } } } while (0)
    ATT_LOADK(0, kA0, kA1); ATT_STOREK(0, kA0, kA1); ATT_LOADV(0, vA0, vA1); ATT_STOREV(0, vA0, vA1); ATT_LOADK(1, kA0, kA1); ATT_STOREK(1, kA0, kA1);
    constexpr bool DEEP = false;
    if (DEEP) { ATT_LOADK(2, kB0, kB1); ATT_LOADV(1, vB0, vB1); }
    __syncthreads();
    f32x16 sc, sn;
    constexpr bool KPF = (TYPE >= 2);
    bf16x8 kfA[4], kfB[4];
    if (KPF) { LAS const unsigned char* Kn_ = lds + KOFF(0) + kset * KBUF + (32 + r) * KROW + hi * 16;
        kfA[0] = *(LAS const bf16x8*)(Kn_); kfA[1] = *(LAS const bf16x8*)(Kn_ + 32); kfA[2] = *(LAS const bf16x8*)(Kn_ + 64); kfA[3] = *(LAS const bf16x8*)(Kn_ + 96); }
    { LAS const unsigned char* Kb_ = lds + KOFF(0) + kset * KBUF + r * KROW + hi * 16;
        const bf16x8 ka_ = *(LAS const bf16x8*)(Kb_), kb_ = *(LAS const bf16x8*)(Kb_ + 32), kc_ = *(LAS const bf16x8*)(Kb_ + 64), kd_ = *(LAS const bf16x8*)(Kb_ + 96);
        f32x16 z_;
#pragma unroll
        for (int i_ = 0; i_ < 16; ++i_) z_[i_] = 0.f;
        sc = MFMA32(ka_, QFRAG(0), z_); sc = MFMA32(kb_, QFRAG(1), sc); sc = MFMA32(kc_, QFRAG(2), sc); sc = MFMA32(kd_, QFRAG(3), sc); }
#define ATT_ITER(j, LK0, LK1, LV0, LV1, SK0, SK1, SV0, SV1, FST, NXT) do { \
        if (TYPE != 3) { if ((j) + 2 < NT) ATT_LOADK((j) + 2, SK0, SK1); if ((j) + 1 < NT) ATT_LOADV((j) + 1, SV0, SV1); } \
        float psum = 0.f; \
        if (TYPE >= 2) { \
            ATT_STEP(sc, sn, true, (j) & 1, 1, (j) & 1, 0, 0, 0, FST, psum, kfA, kfB, ((j) + 1) & 1, 0, NXT); \
            if (TYPE == 3) { if ((j) + 2 < NT) ATT_LOADK((j) + 2, SK0, SK1); if ((j) + 1 < NT) ATT_LOADV((j) + 1, SV0, SV1); } \
            if (NXT) ATT_STEP(sn, sc, true, ((j) + 1) & 1, 0, (j) & 1, 1, 0, 0, FST, psum, kfB, kfA, ((j) + 1) & 1, 1, true); else ATT_STEP(sn, sc, false, 0, 0, (j) & 1, 1, 0, 0, FST, psum, kfB, kfA, 0, 0, false); \
        } else { \
            bool skipj, skipn = true; int mk, pa, mkn = 0, pan = 0; \
            ATT_TILEINFO(j, skipj, mk, pa); \
            if ((j) + 1 < NT) ATT_TILEINFO((j) + 1, skipn, mkn, pan); \
            if (!skipj) { ATT_STEP(sc, sn, true, (j) & 1, 1, (j) & 1, 0, mk, pa, false, psum, kfA, kfB, 0, 0, false); \
                if (!skipn) ATT_STEP(sn, sc, true, ((j) + 1) & 1, 0, (j) & 1, 1, mk, pa, false, psum, kfA, kfB, 0, 0, false); else ATT_STEP(sn, sc, false, 0, 0, (j) & 1, 1, mk, pa, false, psum, kfA, kfB, 0, 0, false); } \
            else if (!skipn) { LAS const unsigned char* Kb_ = lds + KOFF(((j) + 1) & 1) + kset * KBUF + r * KROW + hi * 16; \
                const bf16x8 ka_ = *(LAS const bf16x8*)(Kb_), kb_ = *(LAS const bf16x8*)(Kb_ + 32), kc_ = *(LAS const bf16x8*)(Kb_ + 64), kd_ = *(LAS const bf16x8*)(Kb_ + 96); \
                f32x16 z_; _Pragma("unroll") for (int i_ = 0; i_ < 16; ++i_) z_[i_] = 0.f; \
                sc = MFMA32(ka_, QFRAG(0), z_); sc = MFMA32(kb_, QFRAG(1), sc); sc = MFMA32(kc_, QFRAG(2), sc); sc = MFMA32(kd_, QFRAG(3), sc); } \
        } \
        l += psum; \
        if (TYPE < 2 || !(FST)) ATT_RESCALE(psum); \
        if ((j) + 2 < NT) ATT_STOREK((j) & 1, SK0, SK1); \
        if ((j) + 1 < NT) ATT_STOREV(((j) + 1) & 1, SV0, SV1); \
        __syncthreads(); } while (0)
    if (TYPE >= 2) { for (int j = 0; j < NT - 1; ++j) ATT_ITER(j, kA0, kA1, vA0, vA1, kA0, kA1, vA0, vA1, FASTP, true);
        { const int j = NT - 1; ATT_ITER(j, kA0, kA1, vA0, vA1, kA0, kA1, vA0, vA1, FASTP, false); } }
    else { for (int j = 0; j < NT; ++j) ATT_ITER(j, kA0, kA1, vA0, vA1, kA0, kA1, vA0, vA1, false, false); }
#undef ATT_ITER
#undef QFRAG
#undef ATT_STEP
#undef ATT_RESCALE
#undef SGB
#undef ATT_TB
#undef ATT_LOADK
#undef ATT_LOADV
#undef ATT_STOREK
#undef ATT_STOREV
#undef ATT_TILEINFO
    const float lt = swapsum(l), inv = 1.0f / lt;
    if (TYPE != 3) {
        bf16_t* yrow = Ymix + (size_t)(qrow0 + r) * 512 + h * 64 + 4 * hi;
#pragma unroll
        for (int db = 0; db < NDB; ++db)
#pragma unroll
            for (int g = 0; g < 4; ++g) { bf16_t* yp = yrow + 32 * db + 8 * g; const u32x2 gt = *(const u32x2*)yp;
                u32x2 ov; ov.x = cvtpk(o[db][4 * g] * inv * bflo(gt.x), o[db][4 * g + 1] * inv * bfhi(gt.x)); ov.y = cvtpk(o[db][4 * g + 2] * inv * bflo(gt.y), o[db][4 * g + 3] * inv * bfhi(gt.y));
                if (!dry) *(u32x2*)yp = ov; }
    } else {
        LAS float* ex = (LAS float*)lds + (size_t)wq * 64 * 64 + lane;
        if (kset == 1) {
#pragma unroll
            for (int db = 0; db < NDB; ++db)
#pragma unroll
                for (int i = 0; i < 16; ++i) ex[(db * 16 + i) * 64] = o[db][i] * inv;
        }
        __syncthreads();
        if (kset == 0) {
            const float lam = lamp[0], lam_init = (layer_i == 0) ? 0.2f : 0.35550906759f;
            float ss = 0.f;
#pragma unroll
            for (int db = 0; db < NDB; ++db)
#pragma unroll
                for (int i = 0; i < 16; ++i) { const float v = o[db][i] * inv - lam * ex[(db * 16 + i) * 64]; o[db][i] = v; ss += v * v; }
            ss = swapsum(ss);
            const float rs = (1.0f / sqrtf(ss * (1.f / 128.f) + EPSN)) * (1.f - lam_init);
            bf16_t* yrow = Ymix + (size_t)(qrow0 + r) * 512 + h * 128 + 4 * hi;
#pragma unroll
            for (int db = 0; db < NDB; ++db)
#pragma unroll
                for (int g = 0; g < 4; ++g) { const int d = 32 * db + 8 * g; bf16_t* yp = yrow + d; const u32x2 gt = *(const u32x2*)yp; const f32x4 sl = *(const f32x4*)(subln + d + 4 * hi);
                    u32x2 ov; ov.x = cvtpk(o[db][4 * g] * rs * sl.x * bflo(gt.x), o[db][4 * g + 1] * rs * sl.y * bfhi(gt.x));
                    ov.y = cvtpk(o[db][4 * g + 2] * rs * sl.z * bflo(gt.y), o[db][4 * g + 3] * rs * sl.w * bfhi(gt.y));
                    if (!dry) *(u32x2*)yp = ov; }
        }
        __syncthreads();
    }
}

DI void attn_unit_c2(LAS unsigned char* lds, const bf16_t* __restrict__ Pqk, const bf16_t* __restrict__ Vt, bf16_t* Ymix, int b, int hp, int qb, bool isctx, bool dry, int tid_in,
                     const float* gain_q, const f32x2_t* rope) {
    int tid_op = tid_in; asm volatile("" : "+v"(tid_op));
    const int tid = tid_op, lane = tid & 63, r = lane & 31, hi = lane >> 5;
    const int w = __builtin_amdgcn_readfirstlane(tid >> 6);
    const int qtok = 256 * qb + 32 * w;
    const int ctxrow = MX + b * CTXL, latrow = b * SEQ;
    const int qrow0 = isctx ? (ctxrow + qtok) : (latrow + qtok);
    const int kcol = 2176 + (hp >> 1) * 64, vrow = 640 + (hp >> 1) * 64;
    const int NT = isctx ? 4 : 132;
    bf16x8 qr[2][4];
#pragma unroll
    for (int hh = 0; hh < 2; ++hh) {
        const bf16_t* qp = Pqk + (size_t)(qrow0 + r) * NQK + 1664 + (2 * hp + hh) * 64 + hi * 8;
#pragma unroll
        for (int d0 = 0; d0 < 4; ++d0) qr[hh][d0] = *(const bf16x8*)(qp + d0 * 16);
        float x[4][8]; float ss = 0.f;
#pragma unroll
        for (int d0 = 0; d0 < 4; ++d0)
#pragma unroll
            for (int e = 0; e < 8; ++e) { x[d0][e] = __uint_as_float(((unsigned)(unsigned short)qr[hh][d0][e]) << 16); ss += x[d0][e] * x[d0][e]; }
        ss = swapsum(ss);
        const float rn = (1.0f / sqrtf(ss * (1.f / 64.f) + EPSN));
#pragma unroll
        for (int d0 = 0; d0 < 4; ++d0) { const f32x4 g0 = *(const f32x4*)(gain_q + d0 * 16 + hi * 8), g1 = *(const f32x4*)(gain_q + d0 * 16 + hi * 8 + 4);
            x[d0][0] *= rn * g0.x; x[d0][1] *= rn * g0.y; x[d0][2] *= rn * g0.z; x[d0][3] *= rn * g0.w; x[d0][4] *= rn * g1.x; x[d0][5] *= rn * g1.y; x[d0][6] *= rn * g1.z; x[d0][7] *= rn * g1.w; }
        if (!isctx) { const int t = qtok + r;
#pragma unroll
            for (int a = 0; a < 2; ++a) { const int pos = a ? (t & 63) : (t >> 6); const f32x2_t* rp = rope + pos * 16 + hi * 8;
#pragma unroll
                for (int e = 0; e < 8; ++e) { const f32x2_t cs = rp[e]; const float y0 = x[2 * a][e], y1 = x[2 * a + 1][e]; x[2 * a][e] = y0 * cs.x - y1 * cs.y; x[2 * a + 1][e] = y1 * cs.x + y0 * cs.y; } } }
#pragma unroll
        for (int d0 = 0; d0 < 4; ++d0) { u32x4 t4; t4.x = cvtpk(x[d0][0] * QSCALE, x[d0][1] * QSCALE); t4.y = cvtpk(x[d0][2] * QSCALE, x[d0][3] * QSCALE); t4.z = cvtpk(x[d0][4] * QSCALE, x[d0][5] * QSCALE); t4.w = cvtpk(x[d0][6] * QSCALE, x[d0][7] * QSCALE);
            qr[hh][d0] = __builtin_bit_cast(bf16x8, t4); }
    }
    f32x16 o[2][2];
#pragma unroll
    for (int hh = 0; hh < 2; ++hh)
#pragma unroll
        for (int db = 0; db < 2; ++db)
#pragma unroll
            for (int i = 0; i < 16; ++i) o[hh][db][i] = 0.f;
    float l0 = 0.f, l1 = 0.f;
    const int lrow = tid >> 3, lch = tid & 7;
    u32x4 kA, vA;
#define C2_TB(j) (((j) < 4) ? ctxrow + 64 * (j) : latrow + 64 * ((j) - 4))
#define C2_LOADK(j) do { kA = *(const u32x4*)(Pqk + (size_t)(C2_TB(j) + lrow) * NQK + kcol + lch * 8); } while (0)
#define C2_LOADV(j) do { vA = *(const u32x4*)(Vt + (size_t)(vrow + lrow) * MT + C2_TB(j) + lch * 8); } while (0)
#define C2_STOREK(bf) do { *(LAS u32x4*)(lds + KOFF(bf) + lrow * KROW + lch * 16) = kA; } while (0)
#define C2_STOREV(bf) do { LAS unsigned char* vb_ = lds + VOFF(bf) + lrow * VROW + (lch >> 1) * 32 + (lch & 1) * 8; *(LAS u32x2*)vb_ = (u32x2){vA.x, vA.y}; *(LAS u32x2*)(vb_ + 16) = (u32x2){vA.z, vA.w}; } while (0)
#define C2_KFRAGS(bf, hf) do { LAS const unsigned char* Kn_ = lds + KOFF(bf) + ((hf) * 32 + r) * KROW + hi * 16; \
        kf[0] = *(LAS const bf16x8*)(Kn_); kf[1] = *(LAS const bf16x8*)(Kn_ + 32); kf[2] = *(LAS const bf16x8*)(Kn_ + 64); kf[3] = *(LAS const bf16x8*)(Kn_ + 96); } while (0)
#define C2_STEP(DONEXT, NKBF, NKHF, VBF, VHF) do { \
        LAS const unsigned char* Vb_ = lds + VOFF(VBF) + r * VROW + hi * 16 + (VHF) * 64; \
        const bf16x8 va00_ = *(LAS const bf16x8*)(Vb_), va01_ = *(LAS const bf16x8*)(Vb_ + 32), va10_ = *(LAS const bf16x8*)(Vb_ + 32 * VROW), va11_ = *(LAS const bf16x8*)(Vb_ + 32 * VROW + 32); \
        f32x16 s0_, s1_; { f32x16 z_; _Pragma("unroll") for (int i_ = 0; i_ < 16; ++i_) z_[i_] = 0.f; __builtin_amdgcn_s_setprio(1); \
            s0_ = MFMA32(kf[0], qr[0][0], z_); s1_ = MFMA32(kf[0], qr[1][0], z_); s0_ = MFMA32(kf[1], qr[0][1], s0_); s1_ = MFMA32(kf[1], qr[1][1], s1_); \
            s0_ = MFMA32(kf[2], qr[0][2], s0_); s1_ = MFMA32(kf[2], qr[1][2], s1_); s0_ = MFMA32(kf[3], qr[0][3], s0_); s1_ = MFMA32(kf[3], qr[1][3], s1_); __builtin_amdgcn_s_setprio(0); } \
        if (DONEXT) C2_KFRAGS(NKBF, NKHF); \
        _Pragma("unroll") for (int i_ = 0; i_ < 16; ++i_) s0_[i_] = fexp2(s0_[i_]); \
        u32x4 t0_, t1_; \
        t0_.x = cvtpk(s0_[0], s0_[1]); t0_.y = cvtpk(s0_[2], s0_[3]); t0_.z = cvtpk(s0_[4], s0_[5]); t0_.w = cvtpk(s0_[6], s0_[7]); \
        t1_.x = cvtpk(s0_[8], s0_[9]); t1_.y = cvtpk(s0_[10], s0_[11]); t1_.z = cvtpk(s0_[12], s0_[13]); t1_.w = cvtpk(s0_[14], s0_[15]); \
        const bf16x8 p00_ = __builtin_bit_cast(bf16x8, t0_), p01_ = __builtin_bit_cast(bf16x8, t1_); \
        o[0][0] = MFMA32(va00_, p00_, o[0][0]); o[0][1] = MFMA32(va10_, p00_, o[0][1]); o[0][0] = MFMA32(va01_, p01_, o[0][0]); o[0][1] = MFMA32(va11_, p01_, o[0][1]); \
        _Pragma("unroll") for (int i_ = 0; i_ < 16; ++i_) s1_[i_] = fexp2(s1_[i_]); \
        u32x4 t2_, t3_; \
        t2_.x = cvtpk(s1_[0], s1_[1]); t2_.y = cvtpk(s1_[2], s1_[3]); t2_.z = cvtpk(s1_[4], s1_[5]); t2_.w = cvtpk(s1_[6], s1_[7]); \
        t3_.x = cvtpk(s1_[8], s1_[9]); t3_.y = cvtpk(s1_[10], s1_[11]); t3_.z = cvtpk(s1_[12], s1_[13]); t3_.w = cvtpk(s1_[14], s1_[15]); \
        const bf16x8 p10_ = __builtin_bit_cast(bf16x8, t2_), p11_ = __builtin_bit_cast(bf16x8, t3_); \
        o[1][0] = MFMA32(va00_, p10_, o[1][0]); o[1][1] = MFMA32(va10_, p10_, o[1][1]); o[1][0] = MFMA32(va01_, p11_, o[1][0]); o[1][1] = MFMA32(va11_, p11_, o[1][1]); \
        float a0_ = 0.f, a1_ = 0.f; _Pragma("unroll") for (int i_ = 0; i_ < 16; ++i_) { a0_ += s0_[i_]; a1_ += s1_[i_]; } \
        l0 += a0_; l1 += a1_; } while (0)
    C2_LOADK(0); C2_STOREK(0); C2_LOADV(0); C2_STOREV(0); C2_LOADK(1); C2_STOREK(1);
    __syncthreads();
    bf16x8 kf[4];
    C2_KFRAGS(0, 0);
    for (int j = 0; j < NT - 1; ++j) {
        if (j + 2 < NT) C2_LOADK(j + 2);
        C2_LOADV(j + 1);
        C2_STEP(true, j & 1, 1, j & 1, 0);
        C2_STEP(true, (j + 1) & 1, 0, j & 1, 1);
        if (j + 2 < NT) C2_STOREK(j & 1);
        C2_STOREV((j + 1) & 1);
        __syncthreads();
    }
    { const int j = NT - 1;
        C2_STEP(true, j & 1, 1, j & 1, 0);
        C2_STEP(false, 0, 0, j & 1, 1);
        __syncthreads(); }
#undef C2_TB
#undef C2_LOADK
#undef C2_LOADV
#undef C2_STOREK
#undef C2_STOREV
#undef C2_KFRAGS
#undef C2_STEP
#pragma unroll
    for (int hh = 0; hh < 2; ++hh) {
        const float inv = 1.0f / swapsum(hh ? l1 : l0);
        bf16_t* yrow = Ymix + (size_t)(qrow0 + r) * 512 + (2 * hp + hh) * 64 + 4 * hi;
#pragma unroll
        for (int db = 0; db < 2; ++db)
#pragma unroll
            for (int g = 0; g < 4; ++g) { bf16_t* yp = yrow + 32 * db + 8 * g; const u32x2 gt = *(const u32x2*)yp;
                u32x2 ov; ov.x = cvtpk(o[hh][db][4 * g] * inv * bflo(gt.x), o[hh][db][4 * g + 1] * inv * bfhi(gt.x)); ov.y = cvtpk(o[hh][db][4 * g + 2] * inv * bflo(gt.y), o[hh][db][4 * g + 3] * inv * bfhi(gt.y));
                if (!dry) *(u32x2*)yp = ov; }
    }
}

DI void attn_unit_d2(LAS unsigned char* lds, const bf16_t* __restrict__ Pqk, const bf16_t* __restrict__ Vt, bf16_t* Ymix, int b, int h, int qb, bool isctx, int tid_in,
                     const float* gain_q, const f32x2_t* rope, const float* lamp, int layer_i, const float* subln) {
    int tid_op = tid_in; asm volatile("" : "+v"(tid_op));
    const int tid = tid_op, lane = tid & 63, r = lane & 31, hi = lane >> 5;
    const int w = __builtin_amdgcn_readfirstlane(tid >> 6);
    const int kset = w >> 2, wq = w & 3;
    const int qtok = 128 * qb + 32 * wq;
    const int ctxrow = MX + b * CTXL, latrow = b * SEQ;
    const int qrow0 = isctx ? (ctxrow + qtok) : (latrow + qtok);
    const int kcol = 2816 + 2 * h * 64, vrow = 768 + h * 128;
    const int NT = isctx ? 4 : 132;
    bf16x8 qr[4];
    { const bf16_t* qp = Pqk + (size_t)(qrow0 + r) * NQK + 2304 + (2 * h + kset) * 64 + hi * 8;
#pragma unroll
        for (int d0 = 0; d0 < 4; ++d0) qr[d0] = *(const bf16x8*)(qp + d0 * 16);
        float x[4][8]; float ss = 0.f;
#pragma unroll
        for (int d0 = 0; d0 < 4; ++d0)
#pragma unroll
            for (int e = 0; e < 8; ++e) { x[d0][e] = __uint_as_float(((unsigned)(unsigned short)qr[d0][e]) << 16); ss += x[d0][e] * x[d0][e]; }
        ss = swapsum(ss);
        const float rn = (1.0f / sqrtf(ss * (1.f / 64.f) + EPSN));
#pragma unroll
        for (int d0 = 0; d0 < 4; ++d0) { const f32x4 g0 = *(const f32x4*)(gain_q + d0 * 16 + hi * 8), g1 = *(const f32x4*)(gain_q + d0 * 16 + hi * 8 + 4);
            x[d0][0] *= rn * g0.x; x[d0][1] *= rn * g0.y; x[d0][2] *= rn * g0.z; x[d0][3] *= rn * g0.w; x[d0][4] *= rn * g1.x; x[d0][5] *= rn * g1.y; x[d0][6] *= rn * g1.z; x[d0][7] *= rn * g1.w; }
        if (!isctx) { const int t = qtok + r;
#pragma unroll
            for (int a = 0; a < 2; ++a) { const int pos = a ? (t & 63) : (t >> 6); const f32x2_t* rp = rope + pos * 16 + hi * 8;
#pragma unroll
                for (int e = 0; e < 8; ++e) { const f32x2_t cs = rp[e]; const float y0 = x[2 * a][e], y1 = x[2 * a + 1][e]; x[2 * a][e] = y0 * cs.x - y1 * cs.y; x[2 * a + 1][e] = y1 * cs.x + y0 * cs.y; } } }
#pragma unroll
        for (int d0 = 0; d0 < 4; ++d0) { u32x4 t4; t4.x = cvtpk(x[d0][0] * QSCALE, x[d0][1] * QSCALE); t4.y = cvtpk(x[d0][2] * QSCALE, x[d0][3] * QSCALE); t4.z = cvtpk(x[d0][4] * QSCALE, x[d0][5] * QSCALE); t4.w = cvtpk(x[d0][6] * QSCALE, x[d0][7] * QSCALE);
            qr[d0] = __builtin_bit_cast(bf16x8, t4); }
    }
    f32x16 o[4];
#pragma unroll
    for (int db = 0; db < 4; ++db)
#pragma unroll
        for (int i = 0; i < 16; ++i) o[db][i] = 0.f;
    float l = 0.f;
    const int lrow = tid >> 3, lch = tid & 7;
    u32x4 kA0, kA1, vA0, vA1;
#define D2_TB(j) (((j) < 4) ? ctxrow + 64 * (j) : latrow + 64 * ((j) - 4))
#define D2_LOADK(j) do { const bf16_t* kp_ = Pqk + (size_t)(D2_TB(j) + lrow) * NQK + kcol + lch * 8; kA0 = *(const u32x4*)kp_; kA1 = *(const u32x4*)(kp_ + 64); } while (0)
#define D2_LOADV(j) do { const bf16_t* vp_ = Vt + (size_t)(vrow + lrow) * MT + D2_TB(j) + lch * 8; vA0 = *(const u32x4*)vp_; vA1 = *(const u32x4*)(vp_ + (size_t)64 * MT); } while (0)
#define D2_STOREK(bf) do { LAS unsigned char* sb_ = lds + KOFF(bf); *(LAS u32x4*)(sb_ + lrow * KROW + lch * 16) = kA0; *(LAS u32x4*)(sb_ + KBUF + lrow * KROW + lch * 16) = kA1; } while (0)
#define D2_STOREV(bf) do { LAS unsigned char* vb_ = lds + VOFF(bf) + lrow * VROW + (lch >> 1) * 32 + (lch & 1) * 8; *(LAS u32x2*)vb_ = (u32x2){vA0.x, vA0.y}; *(LAS u32x2*)(vb_ + 16) = (u32x2){vA0.z, vA0.w}; \
        *(LAS u32x2*)(vb_ + 64 * VROW) = (u32x2){vA1.x, vA1.y}; *(LAS u32x2*)(vb_ + 64 * VROW + 16) = (u32x2){vA1.z, vA1.w}; } while (0)
#define D2_KFRAGS(bf, hf) do { LAS const unsigned char* Kn_ = lds + KOFF(bf) + kset * KBUF + ((hf) * 32 + r) * KROW + hi * 16; \
        kf[0] = *(LAS const bf16x8*)(Kn_); kf[1] = *(LAS const bf16x8*)(Kn_ + 32); kf[2] = *(LAS const bf16x8*)(Kn_ + 64); kf[3] = *(LAS const bf16x8*)(Kn_ + 96); } while (0)
#define D2_STEP(DONEXT, NKBF, NKHF, VBF, VHF) do { \
        LAS const unsigned char* Vb_ = lds + VOFF(VBF) + r * VROW + hi * 16 + (VHF) * 64; \
        bf16x8 va_[4][2]; \
        _Pragma("unroll") for (int db_ = 0; db_ < 4; ++db_) { va_[db_][0] = *(LAS const bf16x8*)(Vb_ + db_ * 32 * VROW); va_[db_][1] = *(LAS const bf16x8*)(Vb_ + db_ * 32 * VROW + 32); } \
        f32x16 s_; { f32x16 z_; _Pragma("unroll") for (int i_ = 0; i_ < 16; ++i_) z_[i_] = 0.f; \
            s_ = MFMA32(kf[0], qr[0], z_); s_ = MFMA32(kf[1], qr[1], s_); s_ = MFMA32(kf[2], qr[2], s_); s_ = MFMA32(kf[3], qr[3], s_); } \
        if (DONEXT) D2_KFRAGS(NKBF, NKHF); \
        _Pragma("unroll") for (int i_ = 0; i_ < 16; ++i_) s_[i_] = fexp2(s_[i_]); \
        u32x4 t0_, t1_; \
        t0_.x = cvtpk(s_[0], s_[1]); t0_.y = cvtpk(s_[2], s_[3]); t0_.z = cvtpk(s_[4], s_[5]); t0_.w = cvtpk(s_[6], s_[7]); \
        t1_.x = cvtpk(s_[8], s_[9]); t1_.y = cvtpk(s_[10], s_[11]); t1_.z = cvtpk(s_[12], s_[13]); t1_.w = cvtpk(s_[14], s_[15]); \
        const bf16x8 p0_ = __builtin_bit_cast(bf16x8, t0_), p1_ = __builtin_bit_cast(bf16x8, t1_); \
        _Pragma("unroll") for (int db_ = 0; db_ < 4; ++db_) o[db_] = MFMA32(va_[db_][0], p0_, o[db_]); \
        _Pragma("unroll") for (int db_ = 0; db_ < 4; ++db_) o[db_] = MFMA32(va_[db_][1], p1_, o[db_]); \
        float a_ = 0.f; _Pragma("unroll") for (int i_ = 0; i_ < 16; ++i_) a_ += s_[i_]; \
        l += a_; } while (0)
    D2_LOADK(0); D2_STOREK(0); D2_LOADV(0); D2_STOREV(0); D2_LOADK(1); D2_STOREK(1);
    __syncthreads();
    bf16x8 kf[4];
    D2_KFRAGS(0, 0);
    for (int j = 0; j < NT - 1; ++j) {
        if (j + 2 < NT) D2_LOADK(j + 2);
        D2_LOADV(j + 1);
        D2_STEP(true, j & 1, 1, j & 1, 0);
        D2_STEP(true, (j + 1) & 1, 0, j & 1, 1);
        if (j + 2 < NT) D2_STOREK(j & 1);
        D2_STOREV((j + 1) & 1);
        __syncthreads();
    }
    { const int j = NT - 1;
        D2_STEP(true, j & 1, 1, j & 1, 0);
        D2_STEP(false, 0, 0, j & 1, 1);
        __syncthreads(); }
#undef D2_TB
#undef D2_LOADK
#undef D2_LOADV
#undef D2_STOREK
#undef D2_STOREV
#undef D2_KFRAGS
#undef D2_STEP
    const float inv = 1.0f / swapsum(l);
    LAS float* ex = (LAS float*)lds + (size_t)wq * 64 * 64 + lane;
    if (kset == 1) {
#pragma unroll
        for (int db = 0; db < 4; ++db)
#pragma unroll
            for (int i = 0; i < 16; ++i) ex[(db * 16 + i) * 64] = o[db][i] * inv;
    }
    __syncthreads();
    if (kset == 0) {
        const float lam = lamp[0], lam_init = (layer_i == 0) ? 0.2f : 0.35550906759f;
        float ss = 0.f;
#pragma unroll
        for (int db = 0; db < 4; ++db)
#pragma unroll
            for (int i = 0; i < 16; ++i) { const float v = o[db][i] * inv - lam * ex[(db * 16 + i) * 64]; o[db][i] = v; ss += v * v; }
        ss = swapsum(ss);
        const float rs = (1.0f / sqrtf(ss * (1.f / 128.f) + EPSN)) * (1.f - lam_init);
        bf16_t* yrow = Ymix + (size_t)(qrow0 + r) * 512 + h * 128 + 4 * hi;
#pragma unroll
        for (int db = 0; db < 4; ++db)
#pragma unroll
            for (int g = 0; g < 4; ++g) { const int d = 32 * db + 8 * g; bf16_t* yp = yrow + d; const u32x2 gt = *(const u32x2*)yp; const f32x4 sl = *(const f32x4*)(subln + d + 4 * hi);
                u32x2 ov; ov.x = cvtpk(o[db][4 * g] * rs * sl.x * bflo(gt.x), o[db][4 * g + 1] * rs * sl.y * bfhi(gt.x));
                ov.y = cvtpk(o[db][4 * g + 2] * rs * sl.z * bflo(gt.y), o[db][4 * g + 3] * rs * sl.w * bfhi(gt.y));
                *(u32x2*)yp = ov; }
    }
    __syncthreads();
}

DI void attn_phase(LAS unsigned char* lds, const Params& P, int layer, int v, int G, bool dry, int tid) {
    unsigned char* ws = P.ws;
    const bf16_t* Pqk = (const bf16_t*)(ws + WS_PQK); const bf16_t* Vt = (const bf16_t*)(ws + WS_VT); bf16_t* Y = (bf16_t*)(ws + WS_Y);
    const f32x2_t* rope = (const f32x2_t*)(ws + WS_ROPE);
    const int nu = 512 + (layer == 0 ? 16 : 0);
#define ATT_DECODE(i, NH, NQB) int b_, h_, qb_; bool ic_ = false; if ((i) < 512) { b_ = (i) >> 8; h_ = ((i) / (NQB)) % (NH); qb_ = (i) % (NQB); } \
        else { const int k_ = (i) - 512; ic_ = true; b_ = k_ >> 3; if ((NH) == 4) { h_ = (k_ & 7) >> 1; qb_ = k_ & 1; } else { h_ = k_ & 7; qb_ = 0; } }
#if !defined(ATT_ONLY) || ATT_ONLY == 3
    { const float mfix = fmaxf(0.f, ((const float*)(ws + WS_LAM))[4 + layer * 4 + 3] - 100.0f); bf16_t* Ym = Y + (size_t)3 * MT * 512; const float* gq = P.qk_gain + layer * 512 + 3 * 128;
      if (mfix == 0.f) { for (int i = v; i < nu; i += G) { ATT_DECODE(i, 4, 64);
        attn_unit_d2(lds, Pqk, Vt, Ym, b_, h_, qb_, ic_, tid, gq, rope, (const float*)(ws + WS_LAM) + layer, layer, P.subln_d + layer * 128); } }
      else { for (int i = v; i < nu; i += G) { ATT_DECODE(i, 4, 64);
        attn_unit<3, false>(lds, Pqk, Vt, Ym, b_, h_, qb_, ic_, 0.f, nullptr, (const float*)(ws + WS_LAM) + layer, layer, P.subln_d + layer * 128, dry, 0.f, tid, gq, rope); } } }
#endif
#if !defined(ATT_ONLY) || ATT_ONLY == 2
    { const float mfix = fmaxf(0.f, ((const float*)(ws + WS_LAM))[4 + layer * 4 + 2] - 100.0f); bf16_t* Ym = Y + (size_t)2 * MT * 512; const float* gq = P.qk_gain + layer * 512 + 2 * 128;
      if (mfix == 0.f) { const int nu2 = 256 + (layer == 0 ? 8 : 0);
        for (int i = v; i < nu2; i += G) { int b_, hp_, qb_; bool ic_ = false; if (i < 256) { b_ = i >> 7; hp_ = (i >> 5) & 3; qb_ = i & 31; } else { const int k_ = i - 256; ic_ = true; b_ = k_ >> 2; hp_ = k_ & 3; qb_ = 0; }
          attn_unit_c2(lds, Pqk, Vt, Ym, b_, hp_, qb_, ic_, dry, tid, gq, rope); } }
      else { for (int i = v; i < nu; i += G) { ATT_DECODE(i, 8, 32);
        attn_unit<2, false>(lds, Pqk, Vt, Ym, b_, h_, qb_, ic_, 0.f, nullptr, nullptr, 0, nullptr, dry, 0.f, tid, gq, rope); } } }
#endif
#if !defined(ATT_ONLY) || ATT_ONLY == 0
    { bf16_t* Ym = Y; const float* gq = P.qk_gain + layer * 512;
      for (int i = v; i < nu; i += G) { ATT_DECODE(i, 8, 32);
        attn_unit<0, false>(lds, Pqk, Vt, Ym, b_, h_, qb_, ic_, P.sink_a[layer * 8 + h_] * LOG2E, nullptr, nullptr, 0, nullptr, dry, 0.f, tid, gq, rope); } }
#endif
#if !defined(ATT_ONLY) || ATT_ONLY == 1
    { bf16_t* Ym = Y + (size_t)1 * MT * 512; const float* gq = P.qk_gain + layer * 512 + 1 * 128;
      for (int i = v; i < nu; i += G) { ATT_DECODE(i, 8, 32);
        attn_unit<1, false>(lds, Pqk, Vt, Ym, b_, h_, qb_, ic_, 0.f, P.rpb_b + (size_t)(layer * 8 + h_) * 465, nullptr, 0, nullptr, dry, 0.f, tid, gq, rope); } }
#endif
#undef ATT_DECODE
}

#define XB_TMO      128
#define XB_XCNT(j)  (256  + 64 * (j))
#define XB_XSUB(j)  (1280 + 64 * (j))
#define XB_XGEN(j)  (2304 + 64 * (j))
#define XB_TOP      3328
#define XB_TOPGEN   3392
#define XCD_BAR_WORDS 3456
#define XB_SPIN_CAP (1u << 18)

__device__ __forceinline__ unsigned xb_ld(unsigned* p)              { return __hip_atomic_load(p, __ATOMIC_RELAXED, __HIP_MEMORY_SCOPE_AGENT); }
__device__ __forceinline__ unsigned xb_add(unsigned* p, unsigned v) { return __hip_atomic_fetch_add(p, v, __ATOMIC_RELAXED, __HIP_MEMORY_SCOPE_AGENT); }
__device__ __forceinline__ unsigned xb_xcc_id() { return (unsigned)__builtin_amdgcn_s_getreg((3 << 11) | 20) & 0xFu; }
#define XB_SPIN(cond, bar) do { unsigned _sp = 0; while (cond) { __builtin_amdgcn_s_sleep(1); \
    if ((++_sp & 255u) == 0u) { if (xb_ld(&(bar)[XB_TMO])) break; if (_sp > XB_SPIN_CAP) { atomicAdd(&(bar)[XB_TMO], 1u); break; } } } } while (0)

struct XcdBarrier {
    unsigned* bar; unsigned x;
    volatile LAS unsigned* st;
};

__device__ __forceinline__ XcdBarrier xcd_barrier_post(unsigned* bar, volatile LAS unsigned* st, int tid) {
    XcdBarrier b; b.bar = bar; b.x = xb_xcc_id(); b.st = st;
    if (tid == 0) (void)xb_add(&bar[XB_XCNT(b.x)], 1u);
    return b;
}
__device__ __forceinline__ void xcd_barrier_complete(unsigned* bar, unsigned x, unsigned& nloc, unsigned& nx) {
    const unsigned G = gridDim.x * gridDim.y * gridDim.z;
    unsigned sum, cnt, mine, sp = 0u;
    for (;;) {
        sum = 0u; cnt = 0u; mine = 0u;
#pragma unroll
        for (unsigned j = 0; j < 16; ++j) { const unsigned c = xb_ld(&bar[XB_XCNT(j)]); sum += c; cnt += (c > 0u) ? 1u : 0u; mine = (j == x) ? c : mine; }
        if (sum == G) break;
        __builtin_amdgcn_s_sleep(1);
        if ((++sp & 255u) == 0u) { if (xb_ld(&bar[XB_TMO])) break; if (sp > XB_SPIN_CAP) { atomicAdd(&bar[XB_TMO], 1u); break; } }
    }
    nloc = mine > 0u ? mine : 1u; nx = cnt > 0u ? cnt : 1u;
}

__device__ __forceinline__ void xcd_barrier(const XcdBarrier& b, int tid) {
    asm volatile("s_waitcnt vmcnt(0)" ::: "memory");
    __syncthreads();
    if (tid == 0) {
        unsigned* bar = b.bar;
        __builtin_amdgcn_s_waitcnt(0);
        unsigned nloc = b.st[0], nx = b.st[1];
        if (nloc == 0u) { xcd_barrier_complete(bar, b.x, nloc, nx); b.st[0] = nloc; b.st[1] = nx; }
        const unsigned old = xb_add(&bar[XB_XSUB(b.x)], 1u);
        const unsigned gen = old / nloc;
        if (old + 1u == (gen + 1u) * nloc) {
            __builtin_amdgcn_fence(__ATOMIC_RELEASE, "agent");
            asm volatile("s_waitcnt vmcnt(0)" ::: "memory");
            const unsigned og = xb_add(&bar[XB_TOP], 1u);
            const unsigned tg = og / nx;
            if (og + 1u == (tg + 1u) * nx) xb_add(&bar[XB_TOPGEN], 1u);
            else XB_SPIN(xb_ld(&bar[XB_TOPGEN]) == tg, bar);
            __builtin_amdgcn_fence(__ATOMIC_ACQUIRE, "agent");
            xb_add(&bar[XB_XGEN(b.x)], 1u);
            asm volatile("s_waitcnt vmcnt(0)" ::: "memory");
        } else {
            XB_SPIN(xb_ld(&bar[XB_XGEN(b.x)]) == gen, bar);
            __builtin_amdgcn_fence(__ATOMIC_ACQUIRE, "agent");
            asm volatile("s_waitcnt vmcnt(0)" ::: "memory");
        }
    }
    __syncthreads();
}

constexpr int NPHASE = 15;
__global__ void __launch_bounds__(NTHREADS, 2) dit_fwd(Params P0) {
    extern __shared__ __attribute__((aligned(16))) unsigned char lds_raw[];
    LAS unsigned char* lds = (LAS unsigned char*)lds_raw;
    cg::grid_group grid = cg::this_grid();
    const int G = gridDim.x;
    const int ph_lo = P0.ph_lo, ph_hi = P0.ph_hi;
    const int wave0 = __builtin_amdgcn_readfirstlane((int)threadIdx.x >> 6);
    { const int t0 = wave0 * 64 + (int)__builtin_amdgcn_mbcnt_hi(~0u, __builtin_amdgcn_mbcnt_lo(~0u, 0u)); if (t0 < 2) ((volatile LAS unsigned*)(lds + LDS_MISC))[t0] = 0u; }
    __syncthreads();
    if (ph_hi > 1000) grid.sync();
    XcdBarrier bar = xcd_barrier_post((unsigned*)(P0.ws + WS_BAR), (volatile LAS unsigned*)(lds + LDS_MISC), wave0 * 64 + (int)__builtin_amdgcn_mbcnt_hi(~0u, __builtin_amdgcn_mbcnt_lo(~0u, 0u)));
    for (int ph = ph_lo; ph < ph_hi; ++ph) {
        int wv_op = wave0, bid_op = blockIdx.x; asm volatile("" : "+s"(wv_op), "+s"(bid_op));
        unsigned all1 = ~0u; asm volatile("" : "+s"(all1));
        int tid_op = wv_op * 64 + (int)__builtin_amdgcn_mbcnt_hi(all1, __builtin_amdgcn_mbcnt_lo(all1, 0u)); asm volatile("" : "+v"(tid_op));
        if (ph > ph_lo) xcd_barrier(bar, tid_op);
        typedef const Params __attribute__((address_space(4)))* KArgPtr;
        KArgPtr pp = (KArgPtr)__builtin_amdgcn_kernarg_segment_ptr(); asm volatile("" : "+s"(pp));
        Params P; P.x = pp->x; P.c = pp->c; P.ctx = pp->ctx; P.c_ctx = pp->c_ctx; P.norm_w = pp->norm_w; P.w_ada = pp->w_ada; P.b_ada = pp->b_ada; P.w_in = pp->w_in; P.qk_gain = pp->qk_gain;
        P.sink_a = pp->sink_a; P.rpb_b = pp->rpb_b; P.lam_d = pp->lam_d; P.subln_d = pp->subln_d; P.w_br = pp->w_br; P.w_out = pp->w_out; P.out = pp->out; P.ws = pp->ws; P.ph_lo = 0; P.ph_hi = 0;
        unsigned char* ws = P.ws;
        const int tid = tid_op, bid = bid_op, wave = __builtin_amdgcn_readfirstlane(tid >> 6);
        const int vcu = (G % 8 == 0) ? (bid % 8) * (G / 8) + bid / 8 : bid;
        const int gw = bid * NWAVES + wave, NGW = G * NWAVES;
        const int layer = (ph - 1) / 7, sub = (ph - 1) % 7;
        const float* modl = (const float*)(ws + WS_MOD) + layer * 3 * 3072;
        const float* xcur = (layer == 0) ? P.x : P.out; const float* ccur = (layer == 0) ? P.ctx : (const float*)(ws + WS_CTX1);
        bf16_t* H = (bf16_t*)(ws + WS_H);
        bf16_t* WinT = (bf16_t*)(ws + WS_WIN) + (size_t)layer * NINC * DM;
        const int Ml = (layer == 0) ? MT : MX;
        if (ph == 0) {
#ifndef NO_PRO
            prologue_phase(P, lds, bid, G, tid, (tid & 63), wave);
#ifdef PROBE_MISC
            __syncthreads(); prologue_phase(P, lds, bid, G, tid, (tid & 63), wave);
#endif
#endif
        } else if (sub == 0) {
#ifndef NO_NORM
            norm_phase(xcur, ccur, P.norm_w + layer * DM, modl, H, gw, NGW, (tid & 63));
#ifdef PROBE_MISC
            norm_phase(xcur, ccur, P.norm_w + layer * DM, modl, H, gw, NGW, (tid & 63));
#endif
#endif
        } else if (sub == 2) {
#ifndef NO_PREP
#ifdef PROBE_MISC
            prep_phase((bf16_t*)(ws + WS_PQK), P.qk_gain + layer * 512, (const f32x2_t*)(ws + WS_ROPE), gw, NGW, (tid & 63), ph_hi < 100);
#endif
            prep_phase((bf16_t*)(ws + WS_PQK), P.qk_gain + layer * 512, (const f32x2_t*)(ws + WS_ROPE), gw, NGW, (tid & 63), false);
#endif
        } else if (sub == 3) {
#ifndef NO_ATT
#ifdef PROBE_ATT
            attn_phase(lds, P, layer, vcu, G, ph_hi < 100, tid);
            __syncthreads();
#endif
            attn_phase(lds, P, layer, vcu, G, false, tid);
#endif
        } else if (sub == 1 || sub == 4) {
#if !defined(GEMM_ONLY) || GEMM_ONLY == 1
            if (sub == 1) {
                pg8::Gemm g; EpiAct E; g.K = DM; g.A = H; g.Bt = WinT; g.M = MT; g.N = R_G;
                E.mode = 0; E.O = (bf16_t*)(ws + WS_PQK); E.ldc = NQK; E.act = 0; E.Y = (bf16_t*)(ws + WS_Y); E.VT = (bf16_t*)(ws + WS_VT);
                InProjOrder S; S.init(G, bid, layer); E.offa = S.offa; E.offb = S.offb;
#ifdef PROBE_GEMM
                for (int rep = 0; rep < 2; ++rep)
#endif
                pg8::gemm_phase<EpiAct, InProjOrder, true, true, 1024>(lds, g, S, E, tid);
            } else {
                pg8::Gemm g; EpiAct E; g.K = DM; g.A = H; g.Bt = WinT + (size_t)R_G * DM; g.M = Ml; g.N = 4096;
                E.mode = 1; E.O = (bf16_t*)(ws + WS_G); E.ldc = 4096; E.act = 2; E.Y = nullptr; E.VT = nullptr; E.offa = 0; E.offb = 0;
                pg8::StaticOrder S; S.init(g.M, g.N, G, bid);
                pg8::gemm_phase<EpiAct, pg8::StaticOrder, true, true, 1024>(lds, g, S, E, tid);
            }
#endif
        } else if (sub == 5) {
#if !defined(GEMM_ONLY) || GEMM_ONLY == 5
            pg8::Gemm g; g.A = (bf16_t*)(ws + WS_Y); g.Bt = (bf16_t*)(ws + WS_WBR) + (size_t)(layer * 4) * 1024 * 512; g.M = Ml; g.N = DM; g.K = 512;
            EpiMerge E; E.O = H; E.G0 = (const bf16_t*)(ws + WS_G);
            MergeOrder S; S.init(g.M, G, bid);
            pg8::gemm_phase<EpiMerge, MergeOrder, true, true, 512>(lds, g, S, E, tid);
            if (layer == 0) {
                const int nbusy = (264 > G && 264 - G < G) ? 264 - G : 0;
                if (bid >= nbusy) weight_copies(P, lds, 1, (bid - nbusy) * NWAVES + wave, (G - nbusy) * NWAVES, wave, tid & 63);
            }
#endif
        } else {
#if !defined(GEMM_ONLY) || GEMM_ONLY == 6
            pg8::Gemm g; g.A = H; g.Bt = (bf16_t*)(ws + WS_WOUT) + (size_t)layer * DM * DM; g.M = Ml; g.N = DM; g.K = DM;
            EpiOut E; E.xres = xcur; E.xout = P.out; E.cres = ccur; E.cout = (float*)(ws + WS_CTX1); E.modl = modl;
            pg8::StaticOrder S; S.init(g.M, g.N, G, bid);
            pg8::gemm_phase<EpiOut, pg8::StaticOrder, true, true, 1024>(lds, g, S, E, tid);
#endif
        }
    }
}

extern "C" void kernel_launch(void* const* d_in, const int* in_sizes, int n_in, void* d_out, int out_size, void* d_ws, size_t ws_size, hipStream_t stream) {
    static int grid = 0;
    if (grid == 0) {
        if (n_in != 15 || out_size != MX * DM || ws_size < WS_END) { fprintf(stderr, "kernel_launch: unexpected shapes (n_in %d out %d ws %zu, need %zu)\n", n_in, out_size, ws_size, (size_t)WS_END); grid = -1; return; }
        int dev = 0, cus = 0, per_cu = 0;
        hipGetDevice(&dev); hipDeviceGetAttribute(&cus, hipDeviceAttributeMultiprocessorCount, dev);
        if (hipFuncSetAttribute((const void*)dit_fwd, hipFuncAttributeMaxDynamicSharedMemorySize, LDS_BYTES) != hipSuccess) { fprintf(stderr, "kernel_launch: hipFuncSetAttribute failed\n"); grid = -1; return; }
        if (hipOccupancyMaxActiveBlocksPerMultiprocessor(&per_cu, (const void*)dit_fwd, NTHREADS, LDS_BYTES) != hipSuccess || per_cu < 1) { fprintf(stderr, "kernel_launch: occupancy query failed (%d)\n", per_cu); (void)hipGetLastError(); grid = -1; return; }
        grid = cus * 1;
    }
    if (grid < 0) return;
    Params p{};
    p.x = (const float*)d_in[0]; p.c = (const float*)d_in[1]; p.ctx = (const float*)d_in[2]; p.c_ctx = (const float*)d_in[3]; p.norm_w = (const float*)d_in[4];
    p.w_ada = (const float*)d_in[5]; p.b_ada = (const float*)d_in[6]; p.w_in = (const float*)d_in[7]; p.qk_gain = (const float*)d_in[8]; p.sink_a = (const float*)d_in[9];
    p.rpb_b = (const float*)d_in[10]; p.lam_d = (const float*)d_in[11]; p.subln_d = (const float*)d_in[12]; p.w_br = (const float*)d_in[13]; p.w_out = (const float*)d_in[14];
    p.out = (float*)d_out; p.ws = (unsigned char*)d_ws;
    if (hipMemsetAsync((char*)d_ws + WS_BAR, 0, 16384, stream) != hipSuccess) { fprintf(stderr, "kernel_launch: memset failed\n"); return; }
#ifdef MULTI_LAUNCH
    for (int ph = 0; ph < NPHASE; ++ph) { p.ph_lo = ph; p.ph_hi = ph + 1; hipLaunchKernelGGL(dit_fwd, dim3(grid), dim3(NTHREADS), LDS_BYTES, stream, p); }
#else
    p.ph_lo = 0; p.ph_hi = NPHASE;
    void* args[] = {&p};
    hipError_t e = hipLaunchCooperativeKernel((const void*)dit_fwd, dim3(grid), dim3(NTHREADS), args, LDS_BYTES, stream);
    if (e != hipSuccess) fprintf(stderr, "kernel_launch: cooperative launch failed: %s (grid %d)\n", hipGetErrorString(e), grid);
#endif
}
```

```cpp
#include <hip/hip_runtime.h>
#include <hip/hip_cooperative_groups.h>
#include <cstdio>
#include <cstdint>
namespace cg = cooperative_groups;
namespace pg8 {
#define PG8_LAS __attribute__((address_space(3)))
typedef unsigned short bf16_t;
typedef short bf16x8 __attribute__((ext_vector_type(8)));
typedef float f32x4 __attribute__((ext_vector_type(4)));
typedef unsigned u32x4 __attribute__((ext_vector_type(4)));
constexpr int BM = 256, BK = 64, HALF = 128, HTB = HALF * BK * 2  , STAGE_BYTES = 8 * HTB, NXCD = 8, WGM = 8;

__host__ __device__ __forceinline__ int lds_byte(int r, int c) { const int st = (r >> 4) * 2 + (c >> 5), rr = r & 15, cc = c & 31, ob = rr * 64 + cc * 2; return st * 1024 + (ob ^ (((ob >> 9) & 1) << 5)); }
__host__ __device__ __forceinline__ void stage_rc(int b, int& R, int& C) { const int st = b / 1024, sb = b % 1024, swz = sb ^ (((sb >> 9) & 1) << 5); R = (st >> 1) * 16 + swz / 64; C = (st & 1) * 32 + (swz % 64) / 2; }
__host__ __device__ __forceinline__ int perm32(int rho) { const int n = rho >> 4, i = rho & 15; return 8 * (i >> 2) + 4 * n + (i & 3); }

struct Unit { int pm, pn; };
struct Gemm { const bf16_t* A; const bf16_t* Bt; int M, N, K; };

struct StaticOrder {
    int nM, nN, nwg, G, c;
    __host__ __device__ void init(int M, int N, int G_, int c_) { nM = M / BM; nN = N / BM; nwg = nM * nN; G = G_; c = c_; }
    __host__ __device__ bool next(int i, Unit& u) const {
        const long L = (long)i * G + c; if (L >= nwg) return false;
        int wgid = (int)L; { const int q = nwg / NXCD, r = nwg % NXCD, xcd = wgid % NXCD, off = wgid / NXCD; wgid = (xcd < r ? xcd * (q + 1) : r * (q + 1) + (xcd - r) * q) + off; }
        const int nig = WGM * nN, gid = wgid / nig, fm = gid * WGM, gsz = (nM - fm) < WGM ? (nM - fm) : WGM;
        u.pm = fm + ((wgid % nig) % gsz); u.pn = (wgid % nig) / gsz; return true;
    }
    __device__ __forceinline__ void a_ready(const Unit&) const {}
    __device__ __forceinline__ void done(const Unit&) const {}
};

__device__ __forceinline__ unsigned cvt_pk_bf16(float lo, float hi) { unsigned r; asm volatile("v_cvt_pk_bf16_f32 %0, %1, %2" : "=v"(r) : "v"(lo), "v"(hi)); return r; }
template <class Epi, class Sched, bool ALIGN_EPI = false, bool SP2 = false, int KC = 0>
__device__ __forceinline__ void gemm_phase(PG8_LAS unsigned char* lds, const Gemm g, const Sched& S, const Epi& E, int tid_in) {
    int tid_op = tid_in; asm volatile("" : "+v"(tid_op));
    const int tid = tid_op, wid = __builtin_amdgcn_readfirstlane(tid >> 6), lane = tid & 63, wr = wid >> 2, wc = wid & 3, fr = lane & 15, fq = lane >> 4;
    const int K = KC ? KC : g.K, nt = K / BK;
    unsigned voffA[2], voffB[2];
#pragma unroll
    for (int i = 0; i < 2; ++i) { int R, C; stage_rc(tid * 16 + i * 8192, R, C); const int Rb = Epi::PERM ? ((R & ~31) + perm32(R & 31)) : R;
        voffA[i] = (unsigned)(R * K + C) * 2u; voffB[i] = (unsigned)(Rb * K + C) * 2u; }
    const size_t kstep = (size_t)(BK * 2);
    const size_t hstep = (size_t)HALF * K * 2;
    const size_t tstep = 2 * hstep;
    const unsigned ldsw = (unsigned)wid * 1024u;
    const int aoff = lds_byte(wr * 64 + fr, fq * 8), boff = lds_byte(wc * 32 + fr, fq * 8);
#define PG8_SA(b, h) (((b) * 2 + (h)) * HTB)
#define PG8_SB(b, h) ((4 + (b) * 2 + (h)) * HTB)
#define PG8_STAGE(bufoff, gbase, voff) do { _Pragma("unroll") for (int _i = 0; _i < 2; ++_i) \
        __builtin_amdgcn_global_load_lds((const unsigned*)((const char*)(gbase) + (voff)[_i]), (PG8_LAS unsigned*)(lds + (bufoff) + ldsw + _i * 8192), 16, 0, 0); } while (0)
#define PG8_LDA(dst, b, h) do { _Pragma("unroll") for (int m = 0; m < 4; ++m) _Pragma("unroll") for (int k = 0; k < 2; ++k) dst[m][k] = *(const PG8_LAS bf16x8*)(lds + PG8_SA(b, h) + aoff + m * 2048 + k * 1024); } while (0)
#define PG8_LDB(dst, b, h) do { _Pragma("unroll") for (int n = 0; n < 2; ++n) _Pragma("unroll") for (int k = 0; k < 2; ++k) dst[n][k] = *(const PG8_LAS bf16x8*)(lds + PG8_SB(b, h) + boff + n * 2048 + k * 1024); } while (0)
#define PG8_MMA(ai, bj, At, Bt) do { __builtin_amdgcn_s_setprio(1); _Pragma("unroll") for (int m = 0; m < 4; ++m) _Pragma("unroll") for (int n = 0; n < 2; ++n) _Pragma("unroll") for (int k = 0; k < 2; ++k) \
        acc[ai][bj][m][n] = __builtin_amdgcn_mfma_f32_16x16x32_bf16(Bt[n][k], At[m][k], acc[ai][bj][m][n], 0, 0, 0); __builtin_amdgcn_s_setprio(0); } while (0)
#define PG8_WAIT_V(n) asm volatile("s_waitcnt vmcnt(" #n ")" ::: "memory")
#define PG8_WAIT_L(n) asm volatile("s_waitcnt lgkmcnt(" #n ")" ::: "memory")
#define PG8_BAR __builtin_amdgcn_s_barrier()
#define PG8_SCHED __builtin_amdgcn_sched_barrier(0)
    Unit cur, nxt; int ui = 0;
    if (!S.next(0, cur)) return;
    f32x4 acc[2][2][4][2];
#pragma unroll
    for (int a = 0; a < 2; ++a)
#pragma unroll
        for (int b = 0; b < 2; ++b)
#pragma unroll
            for (int m = 0; m < 4; ++m)
#pragma unroll
                for (int n = 0; n < 2; ++n) acc[a][b][m][n] = (f32x4){0.f, 0.f, 0.f, 0.f};
    bf16x8 At[4][2], B0[2][2], B1[2][2];
    const char* cA = (const char*)g.A + (size_t)cur.pm * tstep; const char* cB = (const char*)g.Bt + (size_t)cur.pn * tstep;
    S.a_ready(cur);
    if constexpr (SP2) {
        PG8_STAGE(PG8_SB(0, 0), cB, voffB); PG8_STAGE(PG8_SB(0, 1), cB + hstep, voffB); PG8_STAGE(PG8_SA(0, 0), cA, voffA); PG8_STAGE(PG8_SA(0, 1), cA + hstep, voffA);
        if (wr == 1) PG8_BAR;
        PG8_WAIT_V(2); PG8_BAR;
        PG8_STAGE(PG8_SB(1, 0), cB + kstep, voffB); PG8_STAGE(PG8_SA(1, 0), cA + kstep, voffA); PG8_STAGE(PG8_SB(1, 1), cB + hstep + kstep, voffB);
        PG8_WAIT_V(6); PG8_BAR;
    } else {
        PG8_STAGE(PG8_SB(0, 0), cB, voffB); PG8_STAGE(PG8_SA(0, 0), cA, voffA); PG8_STAGE(PG8_SB(0, 1), cB + hstep, voffB); PG8_STAGE(PG8_SA(0, 1), cA + hstep, voffA);
        if (wr == 1) PG8_BAR;
        PG8_WAIT_V(4); PG8_BAR;
        PG8_STAGE(PG8_SB(1, 0), cB + kstep, voffB); PG8_STAGE(PG8_SA(1, 0), cA + kstep, voffA); PG8_STAGE(PG8_SB(1, 1), cB + hstep + kstep, voffB);
        PG8_WAIT_V(6); PG8_BAR;
    }
    for (;;) {
        const bool has_next = S.next(ui + 1, nxt);
        const char* nA = has_next ? (const char*)g.A + (size_t)nxt.pm * tstep : cA; const char* nB = has_next ? (const char*)g.Bt + (size_t)nxt.pn * tstep : cB;
        for (int t = 0; t < nt; t += 2) {
            const bool last = (t == nt - 2);
            const char* a1 = cA + (size_t)(t + 1) * kstep;
            const char* a2 = last ? nA : cA + (size_t)(t + 2) * kstep; const char* b2 = last ? nB : cB + (size_t)(t + 2) * kstep;
            const char* a3 = a2 + kstep; const char* b3 = b2 + kstep;
            if (last && has_next) S.a_ready(nxt);
            if constexpr (SP2) {
            PG8_LDB(B0, 0, 0); PG8_LDB(B1, 0, 1); PG8_SCHED; PG8_LDA(At, 0, 0); PG8_STAGE(PG8_SA(1, 1), a1 + hstep, voffA);
            PG8_WAIT_V(8); PG8_WAIT_L(0); PG8_BAR; PG8_MMA(0, 0, At, B0); PG8_MMA(0, 1, At, B1); PG8_BAR; PG8_SCHED;
            PG8_LDA(At, 0, 1); PG8_STAGE(PG8_SB(0, 0), b2, voffB); PG8_STAGE(PG8_SB(0, 1), b2 + hstep, voffB); PG8_STAGE(PG8_SA(0, 0), a2, voffA);
            PG8_WAIT_V(8); PG8_WAIT_L(0); PG8_BAR; PG8_MMA(1, 0, At, B0); PG8_MMA(1, 1, At, B1); PG8_BAR; PG8_SCHED;
            PG8_LDB(B0, 1, 0); PG8_LDB(B1, 1, 1); PG8_SCHED; PG8_LDA(At, 1, 0); PG8_STAGE(PG8_SA(0, 1), a2 + hstep, voffA);
            PG8_WAIT_V(8); PG8_WAIT_L(0); PG8_BAR; PG8_MMA(0, 0, At, B0); PG8_MMA(0, 1, At, B1); PG8_BAR; PG8_SCHED;
            PG8_LDA(At, 1, 1); PG8_STAGE(PG8_SB(1, 0), b3, voffB); PG8_STAGE(PG8_SB(1, 1), b3 + hstep, voffB); PG8_STAGE(PG8_SA(1, 0), a3, voffA);
            PG8_WAIT_V(8); PG8_WAIT_L(0); PG8_BAR; PG8_MMA(1, 0, At, B0); PG8_MMA(1, 1, At, B1); PG8_BAR; PG8_SCHED;
            } else {
            PG8_LDB(B0, 0, 0); PG8_SCHED; PG8_LDA(At, 0, 0); PG8_STAGE(PG8_SA(1, 1), a1 + hstep, voffA);
            PG8_WAIT_L(8); PG8_BAR; PG8_WAIT_L(0); PG8_MMA(0, 0, At, B0); PG8_BAR; PG8_SCHED;
            PG8_LDB(B1, 0, 1); PG8_STAGE(PG8_SB(0, 0), b2, voffB);
            PG8_BAR; PG8_WAIT_L(0); PG8_MMA(0, 1, At, B1); PG8_BAR;
            PG8_LDA(At, 0, 1); PG8_STAGE(PG8_SA(0, 0), a2, voffA);
            PG8_BAR; PG8_WAIT_L(0); PG8_MMA(1, 0, At, B0); PG8_BAR; PG8_SCHED;
            PG8_STAGE(PG8_SB(0, 1), b2 + hstep, voffB);
            PG8_WAIT_V(6); PG8_BAR; PG8_MMA(1, 1, At, B1); PG8_BAR;
            PG8_LDB(B0, 1, 0); PG8_SCHED; PG8_LDA(At, 1, 0); PG8_STAGE(PG8_SA(0, 1), a2 + hstep, voffA);
            PG8_WAIT_L(8); PG8_BAR; PG8_WAIT_L(0); PG8_MMA(0, 0, At, B0); PG8_BAR; PG8_SCHED;
            PG8_LDB(B1, 1, 1); PG8_STAGE(PG8_SB(1, 0), b3, voffB);
            PG8_BAR; PG8_WAIT_L(0); PG8_MMA(0, 1, At, B1); PG8_BAR;
            PG8_LDA(At, 1, 1); PG8_STAGE(PG8_SA(1, 0), a3, voffA);
            PG8_BAR; PG8_WAIT_L(0); PG8_MMA(1, 0, At, B0); PG8_BAR; PG8_SCHED;
            PG8_STAGE(PG8_SB(1, 1), b3 + hstep, voffB);
            PG8_WAIT_V(6); PG8_BAR; PG8_MMA(1, 1, At, B1); PG8_BAR;
            }
        }
        if constexpr (ALIGN_EPI) { if (wr == 0) PG8_BAR; }
        if constexpr (!Epi::AFTER_DRAIN) { E(acc, cur, wr, wc, fr, fq); S.done(cur); }
        if (!has_next) break;
#pragma unroll
        for (int a = 0; a < 2; ++a)
#pragma unroll
            for (int b = 0; b < 2; ++b)
#pragma unroll
                for (int m = 0; m < 4; ++m)
#pragma unroll
                    for (int n = 0; n < 2; ++n) acc[a][b][m][n] = (f32x4){0.f, 0.f, 0.f, 0.f};
        cur = nxt; cA = nA; cB = nB; ++ui;
        if constexpr (ALIGN_EPI) { if (wr == 1) PG8_BAR; }
    }
    PG8_WAIT_V(0);
    if constexpr (!ALIGN_EPI) { if (wr == 0) PG8_BAR; }
    PG8_BAR;
    if constexpr (Epi::AFTER_DRAIN) { E.fused(acc, cur, wr, wc, fr, fq, lds, wid, lane); S.done(cur); }
#undef PG8_SA
#undef PG8_SB
#undef PG8_STAGE
#undef PG8_LDA
#undef PG8_LDB
#undef PG8_MMA
#undef PG8_WAIT_V
#undef PG8_WAIT_L
#undef PG8_BAR
#undef PG8_SCHED
}
}
using pg8::bf16_t; using pg8::bf16x8; using pg8::f32x4; using pg8::u32x4;
#define LAS __attribute__((address_space(3)))
#define DI __device__ __forceinline__
typedef short s16x4 __attribute__((ext_vector_type(4)));
typedef float f32x16 __attribute__((ext_vector_type(16)));
typedef float f32x2_t __attribute__((ext_vector_type(2)));
typedef __bf16 bf16x2_t __attribute__((ext_vector_type(2)));
typedef unsigned u32x2 __attribute__((ext_vector_type(2)));

constexpr int DM = 1024, SEQ = 8192, NBATCH = 2, CTXL = 256;
constexpr int MX = NBATCH * SEQ, MT = MX + NBATCH * CTXL;
constexpr int NQK = 3328, NV = 1280, NINC = 10752;
constexpr int R_PG = 3328, R_G = 5376, R_V = 9472;
constexpr float LOG2E = 1.4426950408889634f, QSCALE = 0.125f * LOG2E, EPSN = 1e-6f;
constexpr int NTHREADS = 512, NWAVES = 8, LDS_BYTES = 131072 + 256, LDS_MISC = 131072;

constexpr size_t MiB = 1u << 20;
constexpr size_t WS_MOD = 0;
constexpr size_t WS_ROPE = 128 * 1024;
constexpr size_t WS_LAM = 256 * 1024;
constexpr size_t WS_BAR = 512 * 1024;
constexpr size_t WS_CTX1 = 1 * MiB;
constexpr size_t WS_WIN = 4 * MiB;
constexpr size_t WS_WBR = 46 * MiB;
constexpr size_t WS_WOUT = 54 * MiB;
constexpr size_t WS_H = 58 * MiB;
constexpr size_t WS_Y = 91 * MiB;
constexpr size_t WS_PQK = 157 * MiB;
constexpr size_t WS_VT = WS_PQK + (size_t)MT * NQK * 2;
constexpr size_t WS_G = WS_PQK;
constexpr size_t WS_END = WS_VT + (size_t)NV * MT * 2;
static_assert(WS_WIN + (size_t)2 * NINC * DM * 2 <= WS_WBR && WS_H + (size_t)MT * DM * 2 <= WS_Y && WS_Y + (size_t)4 * MT * 512 * 2 <= WS_PQK && WS_G + (size_t)MT * 4096 * 2 <= WS_END, "d_ws map");

struct Params {
    const float *x, *c, *ctx, *c_ctx, *norm_w, *w_ada, *b_ada, *w_in, *qk_gain, *sink_a, *rpb_b, *lam_d, *subln_d, *w_br, *w_out;
    float* out; unsigned char* ws; int ph_lo, ph_hi;
};

DI unsigned cvtpk(float lo, float hi) { f32x2_t v = {lo, hi}; bf16x2_t b = __builtin_convertvector(v, bf16x2_t); return __builtin_bit_cast(unsigned, b); }
DI float bflo(unsigned u) { return __uint_as_float(u << 16); }
DI float bfhi(unsigned u) { return __uint_as_float(u & 0xffff0000u); }
DI float wave_sum(float v) {
#pragma unroll
    for (int o = 1; o < 64; o <<= 1) v += __shfl_xor(v, o);
    return v;
}
DI float fexp2(float x) { return __builtin_amdgcn_exp2f(x); }
DI float silu_f(float x) { return x * __builtin_amdgcn_rcpf(1.f + fexp2(-x * LOG2E)); }
DI float sigm_f(float x) { return __builtin_amdgcn_rcpf(1.f + fexp2(-x * LOG2E)); }

struct EpiAct {
    static constexpr bool PERM = true, AFTER_DRAIN = false;
    int mode, ldc, act; bf16_t* O; bf16_t* Y; bf16_t* VT; int offa, offb;
    DI void operator()(const f32x4 (&acc)[2][2][4][2], const pg8::Unit& u, int wr, int wc, int fr, int fq) const {
        int row0 = u.pm * 256 + wr * 64 + fr;
        bf16_t* base = O; int ld = ldc, colt = u.pn * 256, a = act;
        if (mode == 0) { a = 0; if (u.pn < 13) { ld = NQK; } else if (u.pn < 21) { const int g = u.pn - 13; base = Y + (size_t)(g >> 1) * MT * 512; ld = 512; colt = (g & 1) * 256; a = 1; }
            else { base = VT; ld = MT; colt = (u.pn - offb) * 256; row0 = (u.pm - offa) * 256 + wr * 64 + fr; } }
        const int col0 = colt + wc * 32 + 8 * fq;
#pragma unroll
        for (int ai = 0; ai < 2; ++ai)
#pragma unroll
            for (int m = 0; m < 4; ++m) { bf16_t* rowp = base + (size_t)(row0 + ai * 128 + m * 16) * ld + col0;
#pragma unroll
                for (int bj = 0; bj < 2; ++bj) { f32x4 v0 = acc[ai][bj][m][0], v1 = acc[ai][bj][m][1];
                    if (a == 1) {
#pragma unroll
                        for (int e = 0; e < 4; ++e) { v0[e] = silu_f(v0[e]); v1[e] = silu_f(v1[e]); } }
                    else if (a == 2) {
#pragma unroll
                        for (int e = 0; e < 4; ++e) { v0[e] = sigm_f(v0[e]); v1[e] = sigm_f(v1[e]); } }
                    u32x4 w; w.x = cvtpk(v0[0], v0[1]); w.y = cvtpk(v0[2], v0[3]); w.z = cvtpk(v1[0], v1[1]); w.w = cvtpk(v1[2], v1[3]);
                    *(u32x4*)(rowp + bj * 128) = w; } }
    }
};
struct EpiMerge {
    static constexpr bool PERM = true, AFTER_DRAIN = false;
    bf16_t* O; const bf16_t* G0;
    DI void operator()(const f32x4 (&acc)[2][2][4][2], const pg8::Unit& u, int wr, int wc, int fr, int fq) const {
        const int nbr = u.pn >> 2; const bool first = (nbr == 0); const bf16_t* G = G0 + nbr * 1024;
        const int row0 = (u.pm - 66 * nbr) * 256 + wr * 64 + fr;
        const int col0 = (u.pn & 3) * 256 + wc * 32 + 8 * fq;
#pragma unroll
        for (int ai = 0; ai < 2; ++ai) {
            u32x4 g[4][2], o[4][2];
#pragma unroll
            for (int m = 0; m < 4; ++m)
#pragma unroll
                for (int bj = 0; bj < 2; ++bj) { const size_t row = (size_t)(row0 + ai * 128 + m * 16); const int col = col0 + bj * 128;
                    g[m][bj] = *(const u32x4*)(G + row * 4096 + col);
                    if (!first) o[m][bj] = *(const u32x4*)(O + row * 1024 + col); else o[m][bj] = (u32x4){0u, 0u, 0u, 0u}; }
#pragma unroll
            for (int m = 0; m < 4; ++m)
#pragma unroll
                for (int bj = 0; bj < 2; ++bj) { const size_t row = (size_t)(row0 + ai * 128 + m * 16); const int col = col0 + bj * 128;
                    const u32x4 gg = g[m][bj], oo = o[m][bj];
                    f32x4 v0 = acc[ai][bj][m][0], v1 = acc[ai][bj][m][1];
                    v0[0] = v0[0] * bflo(gg.x) + bflo(oo.x); v0[1] = v0[1] * bfhi(gg.x) + bfhi(oo.x); v0[2] = v0[2] * bflo(gg.y) + bflo(oo.y); v0[3] = v0[3] * bfhi(gg.y) + bfhi(oo.y);
                    v1[0] = v1[0] * bflo(gg.z) + bflo(oo.z); v1[1] = v1[1] * bfhi(gg.z) + bfhi(oo.z); v1[2] = v1[2] * bflo(gg.w) + bflo(oo.w); v1[3] = v1[3] * bfhi(gg.w) + bfhi(oo.w);
                    u32x4 w; w.x = cvtpk(v0[0], v0[1]); w.y = cvtpk(v0[2], v0[3]); w.z = cvtpk(v1[0], v1[1]); w.w = cvtpk(v1[2], v1[3]);
                    *(u32x4*)(O + row * 1024 + col) = w; }
            asm volatile("" ::: "memory");
        }
    }
};
struct EpiOut {
    static constexpr bool PERM = true, AFTER_DRAIN = false;
    const float* xres; float* xout; const float* cres; float* cout; const float* modl;
    DI void operator()(const f32x4 (&acc)[2][2][4][2], const pg8::Unit& u, int wr, int wc, int fr, int fq) const {
        const int row0 = u.pm * 256 + wr * 64 + fr;
        const float* res; float* out; const float* gate; int rbase;
        if (u.pm < 64) { res = xres; out = xout; gate = modl + (u.pm >> 5) * 3072 + 2048; rbase = row0; }
        else { res = cres; out = cout; gate = modl + 2 * 3072 + 2048; rbase = row0 - MX; }
        const int col0 = u.pn * 256 + wc * 32 + 8 * fq;
#pragma unroll
        for (int bj = 0; bj < 2; ++bj)
#pragma unroll
            for (int n = 0; n < 2; ++n) { const int col = col0 + bj * 128 + 4 * n; const f32x4 gv = *(const f32x4*)(gate + col);
                f32x4 rv[2][4];
#pragma unroll
                for (int ai = 0; ai < 2; ++ai)
#pragma unroll
                    for (int m = 0; m < 4; ++m) rv[ai][m] = *(const f32x4*)(res + (size_t)(rbase + ai * 128 + m * 16) * 1024 + col);
#pragma unroll
                for (int ai = 0; ai < 2; ++ai)
#pragma unroll
                    for (int m = 0; m < 4; ++m) *(f32x4*)(out + (size_t)(rbase + ai * 128 + m * 16) * 1024 + col) = rv[ai][m] + gv * acc[ai][bj][m][n];
                asm volatile("" ::: "memory"); }
    }
};

struct PackedOrder {
    unsigned long long w0, w1, w2; int n;
    DI void init(int M, int N, int G, int c) {
        pg8::StaticOrder S; S.init(M, N, G, c); w0 = 0ull; w1 = 0ull; w2 = 0ull; n = 0;
#pragma unroll
        for (int i = 0; i < 12; ++i) { pg8::Unit u; const bool ok = S.next(i, u);
            if (ok) { const unsigned long long v = (unsigned long long)((u.pm << 8) | u.pn) << (16 * (i & 3)); if (i < 4) w0 |= v; else if (i < 8) w1 |= v; else w2 |= v; n = i + 1; } }
        w0 = __builtin_amdgcn_readfirstlane((unsigned)w0) | ((unsigned long long)__builtin_amdgcn_readfirstlane((unsigned)(w0 >> 32)) << 32);
        w1 = __builtin_amdgcn_readfirstlane((unsigned)w1) | ((unsigned long long)__builtin_amdgcn_readfirstlane((unsigned)(w1 >> 32)) << 32);
        w2 = __builtin_amdgcn_readfirstlane((unsigned)w2) | ((unsigned long long)__builtin_amdgcn_readfirstlane((unsigned)(w2 >> 32)) << 32);
        n = __builtin_amdgcn_readfirstlane(n);
    }
    DI bool next(int i, pg8::Unit& u) const {
        if (i >= n) return false;
        const unsigned long long x = (i < 4) ? w0 : (i < 8) ? w1 : w2; const unsigned v = (unsigned)(x >> (16 * (i & 3))) & 0xffffu;
        u.pm = (int)(v >> 8); u.pn = (int)(v & 255u); return true;
    }
    DI void a_ready(const pg8::Unit&) const {}
    DI void done(const pg8::Unit&) const {}
};

struct InProjOrder {
    pg8::StaticOrder S0; int G, c, offa, offb;
    DI void init(int G_, int c_, int layer) { S0.init(MT, R_G, G_, c_); G = G_; c = c_; offa = -71 + 42 * layer; offb = 108 - 42 * layer; }
    DI bool next(int i, pg8::Unit& u) const {
        if (S0.next(i, u)) return true;
        const int Lv = i * G + c - 66 * 21; if (Lv >= 5 * 66) return false;
        u.pm = Lv % 5 + offa; u.pn = Lv / 5 + offb; return true;
    }
    DI void a_ready(const pg8::Unit&) const {}
    DI void done(const pg8::Unit&) const {}
};
static_assert((WS_WIN + (size_t)R_V * DM * 2) % (256 * 1024 * 2) == (WS_H % (256 * 1024 * 2)) && ((size_t)NINC * DM * 2) % (256 * 1024 * 2) == 0, "tile-offset trick of InProjOrder");

struct MergeOrder {
    pg8::StaticOrder S0;
    DI void init(int M, int G_, int c_) { S0.init(M, DM, G_, c_); }
    DI bool next(int i, pg8::Unit& u) const { if (!S0.next(i >> 2, u)) return false; const int n = i & 3; u.pm += 66 * n; u.pn += 4 * n; return true; }
    DI void a_ready(const pg8::Unit&) const {}
    DI void done(const pg8::Unit&) const {}
};
static_assert(((size_t)MT * 512 * 2) == (size_t)66 * 256 * 512 * 2 && ((size_t)1024 * 512 * 2) == (size_t)4 * 256 * 512 * 2, "tile-offset trick of MergeOrder");

DI int win_dest_row(int n) {
    if (n >= 6656) return R_G + (n - 6656);
    const int mix = (n >= 4608) ? 3 : (n >= 3328) ? 2 : (n >= 1280) ? 1 : 0;
    const int mstart = (mix == 3) ? 4608 : (mix == 2) ? 3328 : (mix == 1) ? 1280 : 0;
    const int o = n - mstart;
    const bool wide = (mix & 1);
    const int kw = wide ? 512 : 128;
    const int qk0 = (mix == 0) ? 0 : (mix == 1) ? 640 : (mix == 2) ? 1664 : 2304;
    const int v0 = (mix == 0) ? 0 : (mix == 1) ? 128 : (mix == 2) ? 640 : 768;
    if (o < 512 + kw) return qk0 + o;
    if (o < 512 + 2 * kw) return R_V + v0 + (o - 512 - kw);
    return R_PG + mix * 512 + (o - 512 - 2 * kw);
}
DI void transpose_item(const float* W, int K, int N, bf16_t* WT, int drow0, LAS float* scr, int k0, int n0, int lane) {
#pragma unroll 8
    for (int i = 0; i < 32; ++i) { const int kk = 2 * i + (lane >> 5); scr[kk * 33 + (lane & 31)] = W[(size_t)(k0 + kk) * N + n0 + (lane & 31)]; }
    asm volatile("s_waitcnt lgkmcnt(0)" ::: "memory");
    const int c = lane & 7;
#pragma unroll
    for (int j = 0; j < 4; ++j) { const int n = (lane >> 3) + 8 * j; const LAS float* s = scr + (8 * c) * 33 + n;
        u32x4 o; o.x = cvtpk(s[0 * 33], s[1 * 33]); o.y = cvtpk(s[2 * 33], s[3 * 33]); o.z = cvtpk(s[4 * 33], s[5 * 33]); o.w = cvtpk(s[6 * 33], s[7 * 33]);
        *(u32x4*)(WT + (size_t)(drow0 + n) * K + k0 + 8 * c) = o; }
    asm volatile("s_waitcnt lgkmcnt(0)" ::: "memory");
}

DI void prologue_phase(const Params& P, LAS unsigned char* lds, int bid, int G, int tid, int lane, int wave) {
    unsigned char* ws = P.ws;
    if (bid < 192) {
        LAS float* sv = (LAS float*)lds;
        LAS float* red = (LAS float*)(lds + 12288);
        for (int i = tid; i < 3072; i += NTHREADS) { const int v = i >> 10, k = i & 1023; const float a = (v < 2) ? P.c[v * 1024 + k] : P.c_ctx[k]; sv[i] = silu_f(a); }
        __syncthreads();
        const int kc = tid >> 5, cl = tid & 31, j = bid * 32 + cl, l = j / 3072, jj = j % 3072;
        const float* wp = P.w_ada + (size_t)l * 1024 * 3072 + jj;
        float a0 = 0.f, a1 = 0.f, a2 = 0.f;
#pragma unroll 8
        for (int k = kc * 64; k < kc * 64 + 64; ++k) { const float w = wp[(size_t)k * 3072]; a0 += sv[k] * w; a1 += sv[1024 + k] * w; a2 += sv[2048 + k] * w; }
        red[(kc * 32 + cl) * 3 + 0] = a0; red[(kc * 32 + cl) * 3 + 1] = a1; red[(kc * 32 + cl) * 3 + 2] = a2;
        __syncthreads();
        if (tid < 96) { const int c2 = tid & 31, v = tid >> 5; float s = 0.f;
#pragma unroll
            for (int q = 0; q < 16; ++q) s += red[(q * 32 + c2) * 3 + v];
            const int j2 = bid * 32 + c2, l2 = j2 / 3072, jj2 = j2 % 3072;
            ((float*)(ws + WS_MOD))[(l2 * 3 + v) * 3072 + jj2] = s + P.b_ada[l2 * 3072 + jj2]; }
        __syncthreads();
    } else if (bid == 192) {
        for (int e = tid; e < 2048; e += NTHREADS) { const int pos = e >> 4, i = e & 15;
            const float fr = __builtin_amdgcn_exp2f(-(float)i * (13.287712379549449f / 16.f));
            const float ang = (float)pos * fr; double rev = (double)ang * 0.15915494309189535; rev -= __builtin_rint(rev);
            f32x2_t cs; cs.x = __builtin_amdgcn_cosf((float)rev); cs.y = __builtin_amdgcn_sinf((float)rev);
            ((f32x2_t*)(ws + WS_ROPE))[e] = cs; }
    } else if (bid == 193) {
        if (tid < 2) { const float* lf = P.lam_d + tid * 256; float s1 = 0.f, s2 = 0.f;
            for (int d = 0; d < 64; ++d) { s1 += lf[d] * lf[64 + d]; s2 += lf[128 + d] * lf[192 + d]; }
            const float lam_init = (tid == 0) ? 0.2f : 0.35550906759f;
            ((float*)(ws + WS_LAM))[tid] = fexp2(s1 * LOG2E) - fexp2(s2 * LOG2E) + lam_init; }
        if (tid >= 64 && tid < 72) { const int l = (tid - 64) >> 2, mx = (tid - 64) & 3; const float* gq = P.qk_gain + l * 512 + mx * 128; float a = 0.f, c = 0.f;
            for (int d = 0; d < 64; ++d) { a = fmaxf(a, fabsf(gq[d])); c = fmaxf(c, fabsf(gq[64 + d])); }
            ((float*)(ws + WS_LAM))[4 + l * 4 + mx] = 64.0f * a * c * QSCALE * 1.02f; }
    }
    LAS float* scr = (LAS float*)(lds + 20480 + wave * 8448);
    const int gw = bid * NWAVES + wave, NGW = G * NWAVES;
    constexpr int I_IN = 16 * (NINC / 32), I_BR = 8 * 32, I_OUT = 16 * 32, I_L = I_IN + 4 * I_BR + I_OUT;
    for (int it = gw; it < 2 * I_L; it += NGW) {
        const int l = it / I_L; int rI = it % I_L;
        if (rI < I_IN) { const int kb = rI / (NINC / 32), nb = rI % (NINC / 32), n0 = nb * 32;
            transpose_item(P.w_in + (size_t)l * DM * NINC, DM, NINC, (bf16_t*)(ws + WS_WIN) + (size_t)l * NINC * DM, win_dest_row(n0), scr, kb * 64, n0, lane); continue; }
        rI -= I_IN;
        if (rI < 4 * I_BR) { const int n = rI / I_BR, q = rI % I_BR, kb = q / 32, nb = q % 32;
            transpose_item(P.w_br + (size_t)(l * 4 + n) * 512 * 1024, 512, 1024, (bf16_t*)(ws + WS_WBR) + (size_t)(l * 4 + n) * 1024 * 512, nb * 32, scr, kb * 64, nb * 32, lane); continue; }
        rI -= 4 * I_BR;
        { const int kb = rI / 32, nb = rI % 32;
            transpose_item(P.w_out + (size_t)l * DM * DM, DM, DM, (bf16_t*)(ws + WS_WOUT) + (size_t)l * DM * DM, nb * 32, scr, kb * 64, nb * 32, lane); }
    }
}

DI void norm_phase(const float* xsrc, const float* csrc, const float* nw, const float* modl, bf16_t* H, int gw, int NGW, int lane) {
    for (int row = gw; row < MT; row += NGW) {
        const float* src; const float* mv;
        if (row < MX) { src = xsrc + (size_t)row * DM; mv = modl + (row >> 13) * 3072; } else { src = csrc + (size_t)(row - MX) * DM; mv = modl + 2 * 3072; }
        f32x4 v[4]; float ss = 0.f;
#pragma unroll
        for (int j = 0; j < 4; ++j) { v[j] = ((const f32x4*)src)[lane + 64 * j]; ss += (v[j].x * v[j].x + v[j].y * v[j].y) + (v[j].z * v[j].z + v[j].w * v[j].w); }
        const float rn = 1.0f / sqrtf(wave_sum(ss) * (1.f / DM) + EPSN);
#pragma unroll
        for (int j = 0; j < 4; ++j) { const int col = 4 * lane + 256 * j;
            const f32x4 w = *(const f32x4*)(nw + col), sh = *(const f32x4*)(mv + col), sc = *(const f32x4*)(mv + 1024 + col);
            const f32x4 y = (v[j] * rn) * w * (sc + 1.0f) + sh;
            u32x2 o; o.x = cvtpk(y.x, y.y); o.y = cvtpk(y.z, y.w);
            *(u32x2*)(H + (size_t)row * DM + col) = o; }
    }
}

DI void prep_item(bf16_t* p, u32x2 raw, int row, int hh, int l16, const float* gain_l, const f32x2_t* rope, bool dry) {
    int mixer, isk;
    if (hh < 8) { mixer = 0; isk = 0; } else if (hh < 10) { mixer = 0; isk = 1; } else if (hh < 18) { mixer = 1; isk = 0; } else if (hh < 26) { mixer = 1; isk = 1; }
    else if (hh < 34) { mixer = 2; isk = 0; } else if (hh < 36) { mixer = 2; isk = 1; } else if (hh < 44) { mixer = 3; isk = 0; } else { mixer = 3; isk = 1; }
    float y0 = bflo(raw.x), y1 = bfhi(raw.x), y2 = bflo(raw.y), y3 = bfhi(raw.y);
    float ss = (y0 * y0 + y1 * y1) + (y2 * y2 + y3 * y3);
    ss += __shfl_xor(ss, 1); ss += __shfl_xor(ss, 2); ss += __shfl_xor(ss, 4); ss += __shfl_xor(ss, 8);
    const float rn = 1.0f / sqrtf(ss * (1.f / 64.f) + EPSN);
    const f32x4 g = *(const f32x4*)(gain_l + (mixer * 2 + isk) * 64 + l16 * 4);
    y0 = y0 * rn * g.x; y1 = y1 * rn * g.y; y2 = y2 * rn * g.z; y3 = y3 * rn * g.w;
    const float p0 = __shfl_xor(y0, 4), p1 = __shfl_xor(y1, 4), p2 = __shfl_xor(y2, 4), p3 = __shfl_xor(y3, 4);
    if (mixer != 1 && row < MX) {
        const int t = row & (SEQ - 1), pos = (l16 < 8) ? (t >> 6) : (t & 63);
        const f32x2_t* rp = rope + pos * 16 + (l16 & 3) * 4;
        const f32x2_t c0 = rp[0], c1 = rp[1], c2 = rp[2], c3 = rp[3];
        const float sg = (l16 & 4) ? 1.f : -1.f;
        y0 = y0 * c0.x + sg * p0 * c0.y; y1 = y1 * c1.x + sg * p1 * c1.y; y2 = y2 * c2.x + sg * p2 * c2.y; y3 = y3 * c3.x + sg * p3 * c3.y;
    }
    if (!isk) { y0 *= QSCALE; y1 *= QSCALE; y2 *= QSCALE; y3 *= QSCALE; }
    u32x2 o; o.x = cvtpk(y0, y1); o.y = cvtpk(y2, y3);
    if (!dry) *(u32x2*)p = o;
}
DI void prep_phase(bf16_t* Pqk, const float* gain_l, const f32x2_t* rope, int gw, int NGW, int lane, bool dry) {
    const int sub = lane >> 4, l16 = lane & 15;
    constexpr int NIT = MT * 20 / 4;
    for (int it0 = gw * 4; it0 < NIT; it0 += NGW * 4) {
        bf16_t* p[4]; u32x2 raw[4]; int row[4], hh[4];
#pragma unroll
        for (int u = 0; u < 4; ++u) { const int it = min(it0 + u, NIT - 1); const int item = it * 4 + sub; row[u] = item / 20; const int kq = item % 20;
            hh[u] = (kq < 2) ? 8 + kq : (kq < 10) ? 16 + kq : (kq < 12) ? 24 + kq : 32 + kq;
            p[u] = Pqk + (size_t)row[u] * NQK + hh[u] * 64 + l16 * 4; raw[u] = *(const u32x2*)p[u]; }
#pragma unroll
        for (int u = 0; u < 4; ++u) if (it0 + u < NIT) prep_item(p[u], raw[u], row[u], hh[u], l16, gain_l, rope, dry);
    }
}

constexpr int KROW = 144, VROW = 144, KBUF = 64 * KROW, VBUF = 128 * VROW, BIAS_OFF = 4 * KBUF + 2 * VBUF, QOFF = BIAS_OFF + 2048;
static_assert(QOFF + 8 * 4096 <= 131072 && BIAS_OFF + 2048 <= LDS_BYTES && 4 * 64 * 64 * 4 <= BIAS_OFF, "attention LDS map");
#define MFMA32(a, b, c) __builtin_amdgcn_mfma_f32_32x32x16_bf16((a), (b), (c), 0, 0, 0)

DI float swapmax(float m) { auto rr = __builtin_amdgcn_permlane32_swap(__float_as_uint(m), __float_as_uint(m), false, false); return fmaxf(__uint_as_float(rr[0]), __uint_as_float(rr[1])); }
DI float swapsum(float m) { auto rr = __builtin_amdgcn_permlane32_swap(__float_as_uint(m), __float_as_uint(m), false, false); return __uint_as_float(rr[0]) + __uint_as_float(rr[1]); }
#define KOFF(bf) ((bf) * 2 * KBUF)
#define VOFF(bf) (4 * KBUF + (bf) * VBUF)
template <int TYPE, bool FASTP>
DI void attn_unit(LAS unsigned char* lds, const bf16_t* __restrict__ Pqk, const bf16_t* __restrict__ Vt, bf16_t* Ymix,
                  int b, int h, int qb, bool isctx, float sink_l2, const float* rpb_h, const float* lamp, int layer_i, const float* subln, bool dry, float mref_fixed, int tid_in, const float* gain_q, const f32x2_t* rope) {
    constexpr int DV = (TYPE == 3) ? 128 : 64, NDB = DV / 32;
    int tid_op = tid_in; asm volatile("" : "+v"(tid_op));
    const int tid = tid_op, lane = tid & 63, r = lane & 31, hi = lane >> 5;
    const int w = __builtin_amdgcn_readfirstlane(tid >> 6);
    const int kset = (TYPE == 3) ? (w >> 2) : 0, wq = (TYPE == 3) ? (w & 3) : w;
    const int qtok = ((TYPE == 3) ? 128 : 256) * qb + 32 * wq;
    const int ctxrow = MX + b * CTXL, latrow = b * SEQ;
    const int qrow0 = isctx ? (ctxrow + qtok) : (latrow + qtok);
    int qcol, kcol, vrow;
    if (TYPE == 0) { qcol = h * 64; kcol = 512 + (h >> 2) * 64; vrow = (h >> 2) * 64; }
    else if (TYPE == 1) { qcol = 640 + h * 64; kcol = 1152 + h * 64; vrow = 128 + h * 64; }
    else if (TYPE == 2) { qcol = 1664 + h * 64; kcol = 2176 + (h >> 2) * 64; vrow = 640 + (h >> 2) * 64; }
    else { qcol = 2304 + (2 * h + kset) * 64; kcol = 2816 + 2 * h * 64; vrow = 768 + h * 128; }
    int tl0 = 0, tl1 = 0;
    if (!isctx) {
        if (TYPE == 0) { tl0 = max(0, 4 * qb - 2); tl1 = min(128, 4 * qb + 6); }
        else if (TYPE == 1) { tl0 = min(max(4 * qb - 4, 0), 120); tl1 = min(max(4 * qb + 3 - 4, 0), 120) + 8; }
        else { tl0 = 0; tl1 = 128; }
    }
    const int NT = 4 + (tl1 - tl0);
    if (TYPE == 1 && !isctx) { if (tid < 465) ((LAS float*)(lds + BIAS_OFF))[tid] = rpb_h[tid] * LOG2E; }
    bf16x8 qr[4];
    { const bf16_t* qp = Pqk + (size_t)(qrow0 + r) * NQK + qcol + hi * 8;
#pragma unroll
        for (int d0 = 0; d0 < 4; ++d0) qr[d0] = *(const bf16x8*)(qp + d0 * 16); }
    { float x[4][8]; float ss = 0.f;
#pragma unroll
        for (int d0 = 0; d0 < 4; ++d0)
#pragma unroll
            for (int e = 0; e < 8; ++e) { x[d0][e] = __uint_as_float(((unsigned)(unsigned short)qr[d0][e]) << 16); ss += x[d0][e] * x[d0][e]; }
        ss = swapsum(ss);
        const float rn = (1.0f / sqrtf(ss * (1.f / 64.f) + EPSN));
#pragma unroll
        for (int d0 = 0; d0 < 4; ++d0) { const f32x4 g0 = *(const f32x4*)(gain_q + d0 * 16 + hi * 8), g1 = *(const f32x4*)(gain_q + d0 * 16 + hi * 8 + 4);
            x[d0][0] *= rn * g0.x; x[d0][1] *= rn * g0.y; x[d0][2] *= rn * g0.z; x[d0][3] *= rn * g0.w; x[d0][4] *= rn * g1.x; x[d0][5] *= rn * g1.y; x[d0][6] *= rn * g1.z; x[d0][7] *= rn * g1.w; }
        if (TYPE != 1 && !isctx) { const int t = qtok + r;
#pragma unroll
            for (int a = 0; a < 2; ++a) { const int pos = a ? (t & 63) : (t >> 6); const f32x2_t* rp = rope + pos * 16 + hi * 8;
#pragma unroll
                for (int e = 0; e < 8; ++e) { const f32x2_t cs = rp[e]; const float y0 = x[2 * a][e], y1 = x[2 * a + 1][e]; x[2 * a][e] = y0 * cs.x - y1 * cs.y; x[2 * a + 1][e] = y1 * cs.x + y0 * cs.y; } } }
#pragma unroll
        for (int d0 = 0; d0 < 4; ++d0) { u32x4 t4; t4.x = cvtpk(x[d0][0] * QSCALE, x[d0][1] * QSCALE); t4.y = cvtpk(x[d0][2] * QSCALE, x[d0][3] * QSCALE); t4.z = cvtpk(x[d0][4] * QSCALE, x[d0][5] * QSCALE); t4.w = cvtpk(x[d0][6] * QSCALE, x[d0][7] * QSCALE);
            qr[d0] = __builtin_bit_cast(bf16x8, t4); } }
    constexpr bool QLDS = (TYPE == 3 && !FASTP);
    LAS unsigned char* qlds = lds + QOFF + w * 4096 + r * 128 + hi * 16;
    if (QLDS) {
#pragma unroll
        for (int d0 = 0; d0 < 4; ++d0) *(LAS bf16x8*)(qlds + d0 * 32) = qr[d0];
    }
#define QFRAG(d0) (QLDS ? *(LAS const bf16x8*)(qlds + (d0) * 32) : qr[d0])
    f32x16 o[NDB];
#pragma unroll
    for (int db = 0; db < NDB; ++db)
#pragma unroll
        for (int i = 0; i < 16; ++i) o[db][i] = 0.f;
    float mref = 0.f, l = 0.f;
    if (TYPE == 0) { mref = sink_l2; l = (hi == 0) ? 1.f : 0.f; }
    const int lrow = tid >> 3, lch = tid & 7;
    u32x4 kA0, kA1, vA0, vA1, kB0, kB1, vB0, vB1;
#define ATT_TB(j) (((j) < 4) ? ctxrow + 64 * (j) : latrow + 64 * (tl0 + (j) - 4))
#define ATT_LOADK(j, K0, K1) do { const bf16_t* kp_ = Pqk + (size_t)(ATT_TB(j) + lrow) * NQK + kcol + lch * 8; K0 = *(const u32x4*)kp_; if (TYPE == 3) K1 = *(const u32x4*)(kp_ + 64); } while (0)
#define ATT_LOADV(j, V0, V1) do { const bf16_t* vp_ = Vt + (size_t)(vrow + lrow) * MT + ATT_TB(j) + lch * 8; V0 = *(const u32x4*)vp_; if (TYPE == 3) V1 = *(const u32x4*)(vp_ + (size_t)64 * MT); } while (0)
#define ATT_STOREK(bf, K0, K1) do { LAS unsigned char* sb_ = lds + KOFF(bf); *(LAS u32x4*)(sb_ + lrow * KROW + lch * 16) = K0; if (TYPE == 3) *(LAS u32x4*)(sb_ + KBUF + lrow * KROW + lch * 16) = K1; } while (0)
#define ATT_STOREV(bf, V0, V1) do { LAS unsigned char* vb_ = lds + VOFF(bf) + lrow * VROW + (lch >> 1) * 32 + (lch & 1) * 8;     \
        *(LAS u32x2*)vb_ = (u32x2){V0.x, V0.y}; *(LAS u32x2*)(vb_ + 16) = (u32x2){V0.z, V0.w}; \
        if (TYPE == 3) { *(LAS u32x2*)(vb_ + 64 * VROW) = (u32x2){V1.x, V1.y}; *(LAS u32x2*)(vb_ + 64 * VROW + 16) = (u32x2){V1.z, V1.w}; } } while (0)
    const float NEG = -__builtin_inff();
    unsigned okmask = 0u;
    if (TYPE == 1) { const int qc = 32 * (wq & 1) + r, cs = min(max(qc - 8, 0), 48);
#pragma unroll
        for (int i = 0; i < 16; ++i) { const int kc = (i & 3) + 8 * (i >> 2) + 4 * hi; if (kc >= cs && kc < cs + 16) okmask |= 1u << i; if (kc + 32 >= cs && kc + 32 < cs + 16) okmask |= 1u << (16 + i); } }
#define SGB(m, n) __builtin_amdgcn_sched_group_barrier((m), (n), 0)
#define ATT_STEP(SC, SN, DOQK, KBF, KHF, VBF, VHF, MK, PA, FAST, PSUM, KF, KN, NKBF, NKHF, DONEXT) do { \
        LAS const unsigned char* Vb_ = lds + VOFF(VBF) + r * VROW + hi * 16 + (VHF) * 64; \
        bf16x8 va_[NDB][2]; bf16x8 ka_, kb_, kc_, kd_; \
        if (NDB == 2) { _Pragma("unroll") for (int db_ = 0; db_ < NDB; ++db_) { va_[db_][0] = *(LAS const bf16x8*)(Vb_ + db_ * 32 * VROW); va_[db_][1] = *(LAS const bf16x8*)(Vb_ + db_ * 32 * VROW + 32); } } \
        if (KPF) { ka_ = KF[0]; kb_ = KF[1]; kc_ = KF[2]; kd_ = KF[3]; \
            if (DONEXT) { LAS const unsigned char* Kn_ = lds + KOFF(NKBF) + kset * KBUF + ((NKHF) * 32 + r) * KROW + hi * 16; \
                KN[0] = *(LAS const bf16x8*)(Kn_); KN[1] = *(LAS const bf16x8*)(Kn_ + 32); KN[2] = *(LAS const bf16x8*)(Kn_ + 64); KN[3] = *(LAS const bf16x8*)(Kn_ + 96); } } \
        else if (DOQK) { LAS const unsigned char* Kb_ = lds + KOFF(KBF) + kset * KBUF + ((KHF) * 32 + r) * KROW + hi * 16; \
            ka_ = *(LAS const bf16x8*)(Kb_); kb_ = *(LAS const bf16x8*)(Kb_ + 32); kc_ = *(LAS const bf16x8*)(Kb_ + 64); kd_ = *(LAS const bf16x8*)(Kb_ + 96); } \
        if (TYPE == 0 && (MK) == 1) { _Pragma("unroll") for (int i_ = 0; i_ < 16; ++i_) { const int d_ = (PA) + 32 * (VHF) + (i_ & 3) + 8 * (i_ >> 2); if (d_ > 128 || d_ < -128) SC[i_] = NEG; } } \
        if (TYPE == 1 && (MK) == 2) { unsigned okm_ = okmask; int dcb_ = 4 * hi - (32 * (wq & 1) + r) + 15 + (PA) + 32 * (VHF); asm volatile("" : "+v"(okm_), "+v"(dcb_)); \
            LAS const float* bl_ = (LAS const float*)(lds + BIAS_OFF) + dcb_; \
            _Pragma("unroll") for (int i_ = 0; i_ < 16; ++i_) { const float bv_ = bl_[(i_ & 3) + 8 * (i_ >> 2)]; SC[i_] = ((okm_ >> (16 * (VHF) + i_)) & 1u) ? SC[i_] + bv_ : NEG; } } \
        f32x16 z_; _Pragma("unroll") for (int i_ = 0; i_ < 16; ++i_) z_[i_] = 0.f; \
        if (DOQK) SN = MFMA32(ka_, QFRAG(0), z_); \
        _Pragma("unroll") for (int i_ = 0; i_ < 8; ++i_) SC[i_] = (FAST) ? fexp2(SC[i_]) : fexp2(SC[i_] - mref); \
        if (DOQK) SN = MFMA32(kb_, QFRAG(1), SN); \
        u32x4 t0_, t1_; t0_.x = cvtpk(SC[0], SC[1]); t0_.y = cvtpk(SC[2], SC[3]); t0_.z = cvtpk(SC[4], SC[5]); t0_.w = cvtpk(SC[6], SC[7]); \
        if (DOQK) SN = MFMA32(kc_, QFRAG(2), SN); \
        _Pragma("unroll") for (int i_ = 8; i_ < 16; ++i_) SC[i_] = (FAST) ? fexp2(SC[i_]) : fexp2(SC[i_] - mref); \
        if (DOQK) SN = MFMA32(kd_, QFRAG(3), SN); \
        t1_.x = cvtpk(SC[8], SC[9]); t1_.y = cvtpk(SC[10], SC[11]); t1_.z = cvtpk(SC[12], SC[13]); t1_.w = cvtpk(SC[14], SC[15]); \
        const bf16x8 pf0_ = __builtin_bit_cast(bf16x8, t0_), pf1_ = __builtin_bit_cast(bf16x8, t1_); \
        float ps_ = PSUM; \
        _Pragma("unroll") for (int db_ = 0; db_ < NDB; ++db_) { \
            if (NDB != 2) { va_[db_][0] = *(LAS const bf16x8*)(Vb_ + db_ * 32 * VROW); va_[db_][1] = *(LAS const bf16x8*)(Vb_ + db_ * 32 * VROW + 32); } \
            o[db_] = MFMA32(va_[db_][0], pf0_, o[db_]); \
            _Pragma("unroll") for (int i_ = 0; i_ < 8 / NDB; ++i_) ps_ += SC[db_ * (8 / NDB) + i_]; \
            o[db_] = MFMA32(va_[db_][1], pf1_, o[db_]); \
            _Pragma("unroll") for (int i_ = 0; i_ < 8 / NDB; ++i_) ps_ += SC[8 + db_ * (8 / NDB) + i_]; } \
        PSUM = ps_; \
        if (TYPE == 2) { SGB(0x100, ((KPF ? (DONEXT) : (DOQK)) ? 4 : 0) + 2 * NDB); \
            if (DOQK) { SGB(0x008, 1); SGB(0x402, (FAST) ? 8 : 16); SGB(0x008, 1); SGB(0x402, 4); SGB(0x008, 1); SGB(0x402, (FAST) ? 8 : 16); SGB(0x008, 1); SGB(0x402, 4); } \
            _Pragma("unroll") for (int db_ = 0; db_ < 2 * NDB; ++db_) { SGB(0x008, 1); SGB(0x402, 8 / NDB); } } } while (0)
#define ATT_RESCALE(PSUM) do { const float c0_ = swapmax(PSUM); \
        if (__any(c0_ > 8192.0f)) { const float c_ = fmaxf(c0_ * (1.0f / 32.0f), 1.0f), sc_ = __builtin_amdgcn_rcpf(c_); mref += __builtin_amdgcn_logf(c_); l *= sc_; \
            _Pragma("unroll") for (int db_ = 0; db_ < NDB; ++db_) o[db_] = o[db_] * sc_; } } while (0)
#define ATT_TILEINFO(j, skip, mk, pa) do { skip = false; mk = 0; pa = 0; if ((j) >= 4) { \
        if (TYPE == 0) { const int kp0_ = 64 * (tl0 + (j) - 4); skip = (kp0_ + 63 < qtok - 128) || (kp0_ > qtok + 31 + 128); mk = 1; pa = kp0_ - (qtok + r) + 4 * hi; } \
        if (TYPE == 1) { const int kr_ = tl0 + (j) - 4, qrw_ = 4 * qb + (wq >> 1), rs_ = min(max(qrw_ - 4, 0), 120); skip = (kr_ < rs_) || (kr_ >= rs_ + 8); mk = 2; pa = (kr_ - qrw_ + 7) * 31; } } } while (0)
    ATT_LOADK(0, kA0, kA1); ATT_STOREK(0, kA0, kA1); ATT_LOADV(0, vA0, vA1); ATT_STOREV(0, vA0, vA1); ATT_LOADK(1, kA0, kA1); ATT_STOREK(1, kA0, kA1);
    constexpr bool DEEP = false;
    if (DEEP) { ATT_LOADK(2, kB0, kB1); ATT_LOADV(1, vB0, vB1); }
    __syncthreads();
    f32x16 sc, sn;
    constexpr bool KPF = (TYPE >= 2);
    bf16x8 kfA[4], kfB[4];
    if (KPF) { LAS const unsigned char* Kn_ = lds + KOFF(0) + kset * KBUF + (32 + r) * KROW + hi * 16;
        kfA[0] = *(LAS const bf16x8*)(Kn_); kfA[1] = *(LAS const bf16x8*)(Kn_ + 32); kfA[2] = *(LAS const bf16x8*)(Kn_ + 64); kfA[3] = *(LAS const bf16x8*)(Kn_ + 96); }
    { LAS const unsigned char* Kb_ = lds + KOFF(0) + kset * KBUF + r * KROW + hi * 16;
        const bf16x8 ka_ = *(LAS const bf16x8*)(Kb_), kb_ = *(LAS const bf16x8*)(Kb_ + 32), kc_ = *(LAS const bf16x8*)(Kb_ + 64), kd_ = *(LAS const bf16x8*)(Kb_ + 96);
        f32x16 z_;
#pragma unroll
        for (int i_ = 0; i_ < 16; ++i_) z_[i_] = 0.f;
        sc = MFMA32(ka_, QFRAG(0), z_); sc = MFMA32(kb_, QFRAG(1), sc); sc = MFMA32(kc_, QFRAG(2), sc); sc = MFMA32(kd_, QFRAG(3), sc); }
#define ATT_ITER(j, LK0, LK1, LV0, LV1, SK0, SK1, SV0, SV1, FST, NXT) do { \
        if (TYPE != 3) { if ((j) + 2 < NT) ATT_LOADK((j) + 2, SK0, SK1); if ((j) + 1 < NT) ATT_LOADV((j) + 1, SV0, SV1); } \
        float psum = 0.f; \
        if (TYPE >= 2) { \
            ATT_STEP(sc, sn, true, (j) & 1, 1, (j) & 1, 0, 0, 0, FST, psum, kfA, kfB, ((j) + 1) & 1, 0, NXT); \
            if (TYPE == 3) { if ((j) + 2 < NT) ATT_LOADK((j) + 2, SK0, SK1); if ((j) + 1 < NT) ATT_LOADV((j) + 1, SV0, SV1); } \
            if (NXT) ATT_STEP(sn, sc, true, ((j) + 1) & 1, 0, (j) & 1, 1, 0, 0, FST, psum, kfB, kfA, ((j) + 1) & 1, 1, true); else ATT_STEP(sn, sc, false, 0, 0, (j) & 1, 1, 0, 0, FST, psum, kfB, kfA, 0, 0, false); \
        } else { \
            bool skipj, skipn = true; int mk, pa, mkn = 0, pan = 0; \
            ATT_TILEINFO(j, skipj, mk, pa); \
            if ((j) + 1 < NT) ATT_TILEINFO((j) + 1, skipn, mkn, pan); \
            if (!skipj) { ATT_STEP(sc, sn, true, (j) & 1, 1, (j) & 1, 0, mk, pa, false, psum, kfA, kfB, 0, 0, false); \
                if (!skipn) ATT_STEP(sn, sc, true, ((j) + 1) & 1, 0, (j) & 1, 1, mk, pa, false, psum, kfA, kfB, 0, 0, false); else ATT_STEP(sn, sc, false, 0, 0, (j) & 1, 1, mk, pa, false, psum, kfA, kfB, 0, 0, false); } \
            else if (!skipn) { LAS const unsigned char* Kb_ = lds + KOFF(((j) + 1) & 1) + kset * KBUF + r * KROW + hi * 16; \
                const bf16x8 ka_ = *(LAS const bf16x8*)(Kb_), kb_ = *(LAS const bf16x8*)(Kb_ + 32), kc_ = *(LAS const bf16x8*)(Kb_ + 64), kd_ = *(LAS const bf16x8*)(Kb_ + 96); \
                f32x16 z_; _Pragma("unroll") for (int i_ = 0; i_ < 16; ++i_) z_[i_] = 0.f; \
                sc = MFMA32(ka_, QFRAG(0), z_); sc = MFMA32(kb_, QFRAG(1), sc); sc = MFMA32(kc_, QFRAG(2), sc); sc = MFMA32(kd_, QFRAG(3), sc); } \
        } \
        l += psum; \
        if (TYPE < 2 || !(FST)) ATT_RESCALE(psum); \
        if ((j) + 2 < NT) ATT_STOREK((j) & 1, SK0, SK1); \
        if ((j) + 1 < NT) ATT_STOREV(((j) + 1) & 1, SV0, SV1); \
        __syncthreads(); } while (0)
    if (TYPE >= 2) { for (int j = 0; j < NT - 1; ++j) ATT_ITER(j, kA0, kA1, vA0, vA1, kA0, kA1, vA0, vA1, FASTP, true);
        { const int j = NT - 1; ATT_ITER(j, kA0, kA1, vA0, vA1, kA0, kA1, vA0, vA1, FASTP, false); } }
    else { for (int j = 0; j < NT; ++j) ATT_ITER(j, kA0, kA1, vA0, vA1, kA0, kA1, vA0, vA1, false, false); }
#undef ATT_ITER
#undef QFRAG
#undef ATT_STEP
#undef ATT_RESCALE
#undef SGB
#undef ATT_TB
#undef ATT_LOADK
#undef ATT_LOADV
#undef ATT_STOREK
#undef ATT_STOREV
#undef ATT_TILEINFO
    const float lt = swapsum(l), inv = 1.0f / lt;
    if (TYPE != 3) {
        bf16_t* yrow = Ymix + (size_t)(qrow0 + r) * 512 + h * 64 + 4 * hi;
#pragma unroll
        for (int db = 0; db < NDB; ++db)
#pragma unroll
            for (int g = 0; g < 4; ++g) { bf16_t* yp = yrow + 32 * db + 8 * g; const u32x2 gt = *(const u32x2*)yp;
                u32x2 ov; ov.x = cvtpk(o[db][4 * g] * inv * bflo(gt.x), o[db][4 * g + 1] * inv * bfhi(gt.x)); ov.y = cvtpk(o[db][4 * g + 2] * inv * bflo(gt.y), o[db][4 * g + 3] * inv * bfhi(gt.y));
                if (!dry) *(u32x2*)yp = ov; }
    } else {
        LAS float* ex = (LAS float*)lds + (size_t)wq * 64 * 64 + lane;
        if (kset == 1) {
#pragma unroll
            for (int db = 0; db < NDB; ++db)
#pragma unroll
                for (int i = 0; i < 16; ++i) ex[(db * 16 + i) * 64] = o[db][i] * inv;
        }
        __syncthreads();
        if (kset == 0) {
            const float lam = lamp[0], lam_init = (layer_i == 0) ? 0.2f : 0.35550906759f;
            float ss = 0.f;
#pragma unroll
            for (int db = 0; db < NDB; ++db)
#pragma unroll
                for (int i = 0; i < 16; ++i) { const float v = o[db][i] * inv - lam * ex[(db * 16 + i) * 64]; o[db][i] = v; ss += v * v; }
            ss = swapsum(ss);
            const float rs = (1.0f / sqrtf(ss * (1.f / 128.f) + EPSN)) * (1.f - lam_init);
            bf16_t* yrow = Ymix + (size_t)(qrow0 + r) * 512 + h * 128 + 4 * hi;
#pragma unroll
            for (int db = 0; db < NDB; ++db)
#pragma unroll
                for (int g = 0; g < 4; ++g) { const int d = 32 * db + 8 * g; bf16_t* yp = yrow + d; const u32x2 gt = *(const u32x2*)yp; const f32x4 sl = *(const f32x4*)(subln + d + 4 * hi);
                    u32x2 ov; ov.x = cvtpk(o[db][4 * g] * rs * sl.x * bflo(gt.x), o[db][4 * g + 1] * rs * sl.y * bfhi(gt.x));
                    ov.y = cvtpk(o[db][4 * g + 2] * rs * sl.z * bflo(gt.y), o[db][4 * g + 3] * rs * sl.w * bfhi(gt.y));
                    if (!dry) *(u32x2*)yp = ov; }
        }
        __syncthreads();
    }
}

DI void attn_unit_c2(LAS unsigned char* lds, const bf16_t* __restrict__ Pqk, const bf16_t* __restrict__ Vt, bf16_t* Ymix, int b, int hp, int qb, bool isctx, bool dry, int tid_in,
                     const float* gain_q, const f32x2_t* rope) {
    int tid_op = tid_in; asm volatile("" : "+v"(tid_op));
    const int tid = tid_op, lane = tid & 63, r = lane & 31, hi = lane >> 5;
    const int w = __builtin_amdgcn_readfirstlane(tid >> 6);
    const int qtok = 256 * qb + 32 * w;
    const int ctxrow = MX + b * CTXL, latrow = b * SEQ;
    const int qrow0 = isctx ? (ctxrow + qtok) : (latrow + qtok);
    const int kcol = 2176 + (hp >> 1) * 64, vrow = 640 + (hp >> 1) * 64;
    const int NT = isctx ? 4 : 132;
    bf16x8 qr[2][4];
#pragma unroll
    for (int hh = 0; hh < 2; ++hh) {
        const bf16_t* qp = Pqk + (size_t)(qrow0 + r) * NQK + 1664 + (2 * hp + hh) * 64 + hi * 8;
#pragma unroll
        for (int d0 = 0; d0 < 4; ++d0) qr[hh][d0] = *(const bf16x8*)(qp + d0 * 16);
        float x[4][8]; float ss = 0.f;
#pragma unroll
        for (int d0 = 0; d0 < 4; ++d0)
#pragma unroll
            for (int e = 0; e < 8; ++e) { x[d0][e] = __uint_as_float(((unsigned)(unsigned short)qr[hh][d0][e]) << 16); ss += x[d0][e] * x[d0][e]; }
        ss = swapsum(ss);
        const float rn = (1.0f / sqrtf(ss * (1.f / 64.f) + EPSN));
#pragma unroll
        for (int d0 = 0; d0 < 4; ++d0) { const f32x4 g0 = *(const f32x4*)(gain_q + d0 * 16 + hi * 8), g1 = *(const f32x4*)(gain_q + d0 * 16 + hi * 8 + 4);
            x[d0][0] *= rn * g0.x; x[d0][1] *= rn * g0.y; x[d0][2] *= rn * g0.z; x[d0][3] *= rn * g0.w; x[d0][4] *= rn * g1.x; x[d0][5] *= rn * g1.y; x[d0][6] *= rn * g1.z; x[d0][7] *= rn * g1.w; }
        if (!isctx) { const int t = qtok + r;
#pragma unroll
            for (int a = 0; a < 2; ++a) { const int pos = a ? (t & 63) : (t >> 6); const f32x2_t* rp = rope + pos * 16 + hi * 8;
#pragma unroll
                for (int e = 0; e < 8; ++e) { const f32x2_t cs = rp[e]; const float y0 = x[2 * a][e], y1 = x[2 * a + 1][e]; x[2 * a][e] = y0 * cs.x - y1 * cs.y; x[2 * a + 1][e] = y1 * cs.x + y0 * cs.y; } } }
#pragma unroll
        for (int d0 = 0; d0 < 4; ++d0) { u32x4 t4; t4.x = cvtpk(x[d0][0] * QSCALE, x[d0][1] * QSCALE); t4.y = cvtpk(x[d0][2] * QSCALE, x[d0][3] * QSCALE); t4.z = cvtpk(x[d0][4] * QSCALE, x[d0][5] * QSCALE); t4.w = cvtpk(x[d0][6] * QSCALE, x[d0][7] * QSCALE);
            qr[hh][d0] = __builtin_bit_cast(bf16x8, t4); }
    }
    f32x16 o[2][2];
#pragma unroll
    for (int hh = 0; hh < 2; ++hh)
#pragma unroll
        for (int db = 0; db < 2; ++db)
#pragma unroll
            for (int i = 0; i < 16; ++i) o[hh][db][i] = 0.f;
    float l0 = 0.f, l1 = 0.f;
    const int lrow = tid >> 3, lch = tid & 7;
    u32x4 kA, vA;
#define C2_TB(j) (((j) < 4) ? ctxrow + 64 * (j) : latrow + 64 * ((j) - 4))
#define C2_LOADK(j) do { kA = *(const u32x4*)(Pqk + (size_t)(C2_TB(j) + lrow) * NQK + kcol + lch * 8); } while (0)
#define C2_LOADV(j) do { vA = *(const u32x4*)(Vt + (size_t)(vrow + lrow) * MT + C2_TB(j) + lch * 8); } while (0)
#define C2_STOREK(bf) do { *(LAS u32x4*)(lds + KOFF(bf) + lrow * KROW + lch * 16) = kA; } while (0)
#define C2_STOREV(bf) do { LAS unsigned char* vb_ = lds + VOFF(bf) + lrow * VROW + (lch >> 1) * 32 + (lch & 1) * 8; *(LAS u32x2*)vb_ = (u32x2){vA.x, vA.y}; *(LAS u32x2*)(vb_ + 16) = (u32x2){vA.z, vA.w}; } while (0)
#define C2_KFRAGS(bf, hf) do { LAS const unsigned char* Kn_ = lds + KOFF(bf) + ((hf) * 32 + r) * KROW + hi * 16; \
        kf[0] = *(LAS const bf16x8*)(Kn_); kf[1] = *(LAS const bf16x8*)(Kn_ + 32); kf[2] = *(LAS const bf16x8*)(Kn_ + 64); kf[3] = *(LAS const bf16x8*)(Kn_ + 96); } while (0)
#define C2_STEP(DONEXT, NKBF, NKHF, VBF, VHF) do { \
        LAS const unsigned char* Vb_ = lds + VOFF(VBF) + r * VROW + hi * 16 + (VHF) * 64; \
        const bf16x8 va00_ = *(LAS const bf16x8*)(Vb_), va01_ = *(LAS const bf16x8*)(Vb_ + 32), va10_ = *(LAS const bf16x8*)(Vb_ + 32 * VROW), va11_ = *(LAS const bf16x8*)(Vb_ + 32 * VROW + 32); \
        f32x16 s0_, s1_; { f32x16 z_; _Pragma("unroll") for (int i_ = 0; i_ < 16; ++i_) z_[i_] = 0.f; __builtin_amdgcn_s_setprio(1); \
            s0_ = MFMA32(kf[0], qr[0][0], z_); s1_ = MFMA32(kf[0], qr[1][0], z_); s0_ = MFMA32(kf[1], qr[0][1], s0_); s1_ = MFMA32(kf[1], qr[1][1], s1_); \
            s0_ = MFMA32(kf[2], qr[0][2], s0_); s1_ = MFMA32(kf[2], qr[1][2], s1_); s0_ = MFMA32(kf[3], qr[0][3], s0_); s1_ = MFMA32(kf[3], qr[1][3], s1_); __builtin_amdgcn_s_setprio(0); } \
        if (DONEXT) C2_KFRAGS(NKBF, NKHF); \
        _Pragma("unroll") for (int i_ = 0; i_ < 16; ++i_) s0_[i_] = fexp2(s0_[i_]); \
        u32x4 t0_, t1_; \
        t0_.x = cvtpk(s0_[0], s0_[1]); t0_.y = cvtpk(s0_[2], s0_[3]); t0_.z = cvtpk(s0_[4], s0_[5]); t0_.w = cvtpk(s0_[6], s0_[7]); \
        t1_.x = cvtpk(s0_[8], s0_[9]); t1_.y = cvtpk(s0_[10], s0_[11]); t1_.z = cvtpk(s0_[12], s0_[13]); t1_.w = cvtpk(s0_[14], s0_[15]); \
        const bf16x8 p00_ = __builtin_bit_cast(bf16x8, t0_), p01_ = __builtin_bit_cast(bf16x8, t1_); \
        o[0][0] = MFMA32(va00_, p00_, o[0][0]); o[0][1] = MFMA32(va10_, p00_, o[0][1]); o[0][0] = MFMA32(va01_, p01_, o[0][0]); o[0][1] = MFMA32(va11_, p01_, o[0][1]); \
        _Pragma("unroll") for (int i_ = 0; i_ < 16; ++i_) s1_[i_] = fexp2(s1_[i_]); \
        u32x4 t2_, t3_; \
        t2_.x = cvtpk(s1_[0], s1_[1]); t2_.y = cvtpk(s1_[2], s1_[3]); t2_.z = cvtpk(s1_[4], s1_[5]); t2_.w = cvtpk(s1_[6], s1_[7]); \
        t3_.x = cvtpk(s1_[8], s1_[9]); t3_.y = cvtpk(s1_[10], s1_[11]); t3_.z = cvtpk(s1_[12], s1_[13]); t3_.w = cvtpk(s1_[14], s1_[15]); \
        const bf16x8 p10_ = __builtin_bit_cast(bf16x8, t2_), p11_ = __builtin_bit_cast(bf16x8, t3_); \
        o[1][0] = MFMA32(va00_, p10_, o[1][0]); o[1][1] = MFMA32(va10_, p10_, o[1][1]); o[1][0] = MFMA32(va01_, p11_, o[1][0]); o[1][1] = MFMA32(va11_, p11_, o[1][1]); \
        float a0_ = 0.f, a1_ = 0.f; _Pragma("unroll") for (int i_ = 0; i_ < 16; ++i_) { a0_ += s0_[i_]; a1_ += s1_[i_]; } \
        l0 += a0_; l1 += a1_; } while (0)
    C2_LOADK(0); C2_STOREK(0); C2_LOADV(0); C2_STOREV(0); C2_LOADK(1); C2_STOREK(1);
    __syncthreads();
    bf16x8 kf[4];
    C2_KFRAGS(0, 0);
    for (int j = 0; j < NT - 1; ++j) {
        if (j + 2 < NT) C2_LOADK(j + 2);
        C2_LOADV(j + 1);
        C2_STEP(true, j & 1, 1, j & 1, 0);
        C2_STEP(true, (j + 1) & 1, 0, j & 1, 1);
        if (j + 2 < NT) C2_STOREK(j & 1);
        C2_STOREV((j + 1) & 1);
        __syncthreads();
    }
    { const int j = NT - 1;
        C2_STEP(true, j & 1, 1, j & 1, 0);
        C2_STEP(false, 0, 0, j & 1, 1);
        __syncthreads(); }
#undef C2_TB
#undef C2_LOADK
#undef C2_LOADV
#undef C2_STOREK
#undef C2_STOREV
#undef C2_KFRAGS
#undef C2_STEP
#pragma unroll
    for (int hh = 0; hh < 2; ++hh) {
        const float inv = 1.0f / swapsum(hh ? l1 : l0);
        bf16_t* yrow = Ymix + (size_t)(qrow0 + r) * 512 + (2 * hp + hh) * 64 + 4 * hi;
#pragma unroll
        for (int db = 0; db < 2; ++db)
#pragma unroll
            for (int g = 0; g < 4; ++g) { bf16_t* yp = yrow + 32 * db + 8 * g; const u32x2 gt = *(const u32x2*)yp;
                u32x2 ov; ov.x = cvtpk(o[hh][db][4 * g] * inv * bflo(gt.x), o[hh][db][4 * g + 1] * inv * bfhi(gt.x)); ov.y = cvtpk(o[hh][db][4 * g + 2] * inv * bflo(gt.y), o[hh][db][4 * g + 3] * inv * bfhi(gt.y));
                if (!dry) *(u32x2*)yp = ov; }
    }
}

DI void attn_unit_d2(LAS unsigned char* lds, const bf16_t* __restrict__ Pqk, const bf16_t* __restrict__ Vt, bf16_t* Ymix, int b, int h, int qb, bool isctx, int tid_in,
                     const float* gain_q, const f32x2_t* rope, const float* lamp, int layer_i, const float* subln) {
    int tid_op = tid_in; asm volatile("" : "+v"(tid_op));
    const int tid = tid_op, lane = tid & 63, r = lane & 31, hi = lane >> 5;
    const int w = __builtin_amdgcn_readfirstlane(tid >> 6);
    const int kset = w >> 2, wq = w & 3;
    const int qtok = 128 * qb + 32 * wq;
    const int ctxrow = MX + b * CTXL, latrow = b * SEQ;
    const int qrow0 = isctx ? (ctxrow + qtok) : (latrow + qtok);
    const int kcol = 2816 + 2 * h * 64, vrow = 768 + h * 128;
    const int NT = isctx ? 4 : 132;
    bf16x8 qr[4];
    { const bf16_t* qp = Pqk + (size_t)(qrow0 + r) * NQK + 2304 + (2 * h + kset) * 64 + hi * 8;
#pragma unroll
        for (int d0 = 0; d0 < 4; ++d0) qr[d0] = *(const bf16x8*)(qp + d0 * 16);
        float x[4][8]; float ss = 0.f;
#pragma unroll
        for (int d0 = 0; d0 < 4; ++d0)
#pragma unroll
            for (int e = 0; e < 8; ++e) { x[d0][e] = __uint_as_float(((unsigned)(unsigned short)qr[d0][e]) << 16); ss += x[d0][e] * x[d0][e]; }
        ss = swapsum(ss);
        const float rn = (1.0f / sqrtf(ss * (1.f / 64.f) + EPSN));
#pragma unroll
        for (int d0 = 0; d0 < 4; ++d0) { const f32x4 g0 = *(const f32x4*)(gain_q + d0 * 16 + hi * 8), g1 = *(const f32x4*)(gain_q + d0 * 16 + hi * 8 + 4);
            x[d0][0] *= rn * g0.x; x[d0][1] *= rn * g0.y; x[d0][2] *= rn * g0.z; x[d0][3] *= rn * g0.w; x[d0][4] *= rn * g1.x; x[d0][5] *= rn * g1.y; x[d0][6] *= rn * g1.z; x[d0][7] *= rn * g1.w; }
        if (!isctx) { const int t = qtok + r;
#pragma unroll
            for (int a = 0; a < 2; ++a) { const int pos = a ? (t & 63) : (t >> 6); const f32x2_t* rp = rope + pos * 16 + hi * 8;
#pragma unroll
                for (int e = 0; e < 8; ++e) { const f32x2_t cs = rp[e]; const float y0 = x[2 * a][e], y1 = x[2 * a + 1][e]; x[2 * a][e] = y0 * cs.x - y1 * cs.y; x[2 * a + 1][e] = y1 * cs.x + y0 * cs.y; } } }
#pragma unroll
        for (int d0 = 0; d0 < 4; ++d0) { u32x4 t4; t4.x = cvtpk(x[d0][0] * QSCALE, x[d0][1] * QSCALE); t4.y = cvtpk(x[d0][2] * QSCALE, x[d0][3] * QSCALE); t4.z = cvtpk(x[d0][4] * QSCALE, x[d0][5] * QSCALE); t4.w = cvtpk(x[d0][6] * QSCALE, x[d0][7] * QSCALE);
            qr[d0] = __builtin_bit_cast(bf16x8, t4); }
    }
    f32x16 o[4];
#pragma unroll
    for (int db = 0; db < 4; ++db)
#pragma unroll
        for (int i = 0; i < 16; ++i) o[db][i] = 0.f;
    float l = 0.f;
    const int lrow = tid >> 3, lch = tid & 7;
    u32x4 kA0, kA1, vA0, vA1;
#define D2_TB(j) (((j) < 4) ? ctxrow + 64 * (j) : latrow + 64 * ((j) - 4))
#define D2_LOADK(j) do { const bf16_t* kp_ = Pqk + (size_t)(D2_TB(j) + lrow) * NQK + kcol + lch * 8; kA0 = *(const u32x4*)kp_; kA1 = *(const u32x4*)(kp_ + 64); } while (0)
#define D2_LOADV(j) do { const bf16_t* vp_ = Vt + (size_t)(vrow + lrow) * MT + D2_TB(j) + lch * 8; vA0 = *(const u32x4*)vp_; vA1 = *(const u32x4*)(vp_ + (size_t)64 * MT); } while (0)
#define D2_STOREK(bf) do { LAS unsigned char* sb_ = lds + KOFF(bf); *(LAS u32x4*)(sb_ + lrow * KROW + lch * 16) = kA0; *(LAS u32x4*)(sb_ + KBUF + lrow * KROW + lch * 16) = kA1; } while (0)
#define D2_STOREV(bf) do { LAS unsigned char* vb_ = lds + VOFF(bf) + lrow * VROW + (lch >> 1) * 32 + (lch & 1) * 8; *(LAS u32x2*)vb_ = (u32x2){vA0.x, vA0.y}; *(LAS u32x2*)(vb_ + 16) = (u32x2){vA0.z, vA0.w}; \
        *(LAS u32x2*)(vb_ + 64 * VROW) = (u32x2){vA1.x, vA1.y}; *(LAS u32x2*)(vb_ + 64 * VROW + 16) = (u32x2){vA1.z, vA1.w}; } while (0)
#define D2_KFRAGS(bf, hf) do { LAS const unsigned char* Kn_ = lds + KOFF(bf) + kset * KBUF + ((hf) * 32 + r) * KROW + hi * 16; \
        kf[0] = *(LAS const bf16x8*)(Kn_); kf[1] = *(LAS const bf16x8*)(Kn_ + 32); kf[2] = *(LAS const bf16x8*)(Kn_ + 64); kf[3] = *(LAS const bf16x8*)(Kn_ + 96); } while (0)
#define D2_STEP(DONEXT, NKBF, NKHF, VBF, VHF) do { \
        LAS const unsigned char* Vb_ = lds + VOFF(VBF) + r * VROW + hi * 16 + (VHF) * 64; \
        bf16x8 va_[4][2]; \
        _Pragma("unroll") for (int db_ = 0; db_ < 4; ++db_) { va_[db_][0] = *(LAS const bf16x8*)(Vb_ + db_ * 32 * VROW); va_[db_][1] = *(LAS const bf16x8*)(Vb_ + db_ * 32 * VROW + 32); } \
        f32x16 s_; { f32x16 z_; _Pragma("unroll") for (int i_ = 0; i_ < 16; ++i_) z_[i_] = 0.f; \
            s_ = MFMA32(kf[0], qr[0], z_); s_ = MFMA32(kf[1], qr[1], s_); s_ = MFMA32(kf[2], qr[2], s_); s_ = MFMA32(kf[3], qr[3], s_); } \
        if (DONEXT) D2_KFRAGS(NKBF, NKHF); \
        _Pragma("unroll") for (int i_ = 0; i_ < 16; ++i_) s_[i_] = fexp2(s_[i_]); \
        u32x4 t0_, t1_; \
        t0_.x = cvtpk(s_[0], s_[1]); t0_.y = cvtpk(s_[2], s_[3]); t0_.z = cvtpk(s_[4], s_[5]); t0_.w = cvtpk(s_[6], s_[7]); \
        t1_.x = cvtpk(s_[8], s_[9]); t1_.y = cvtpk(s_[10], s_[11]); t1_.z = cvtpk(s_[12], s_[13]); t1_.w = cvtpk(s_[14], s_[15]); \
        const bf16x8 p0_ = __builtin_bit_cast(bf16x8, t0_), p1_ = __builtin_bit_cast(bf16x8, t1_); \
        _Pragma("unroll") for (int db_ = 0; db_ < 4; ++db_) o[db_] = MFMA32(va_[db_][0], p0_, o[db_]); \
        _Pragma("unroll") for (int db_ = 0; db_ < 4; ++db_) o[db_] = MFMA32(va_[db_][1], p1_, o[db_]); \
        float a_ = 0.f; _Pragma("unroll") for (int i_ = 0; i_ < 16; ++i_) a_ += s_[i_]; \
        l += a_; } while (0)
    D2_LOADK(0); D2_STOREK(0); D2_LOADV(0); D2_STOREV(0); D2_LOADK(1); D2_STOREK(1);
    __syncthreads();
    bf16x8 kf[4];
    D2_KFRAGS(0, 0);
    for (int j = 0; j < NT - 1; ++j) {
        if (j + 2 < NT) D2_LOADK(j + 2);
        D2_LOADV(j + 1);
        D2_STEP(true, j & 1, 1, j & 1, 0);
        D2_STEP(true, (j + 1) & 1, 0, j & 1, 1);
        if (j + 2 < NT) D2_STOREK(j & 1);
        D2_STOREV((j + 1) & 1);
        __syncthreads();
    }
    { const int j = NT - 1;
        D2_STEP(true, j & 1, 1, j & 1, 0);
        D2_STEP(false, 0, 0, j & 1, 1);
        __syncthreads(); }
#undef D2_TB
#undef D2_LOADK
#undef D2_LOADV
#undef D2_STOREK
#undef D2_STOREV
#undef D2_KFRAGS
#undef D2_STEP
    const float inv = 1.0f / swapsum(l);
    LAS float* ex = (LAS float*)lds + (size_t)wq * 64 * 64 + lane;
    if (kset == 1) {
#pragma unroll
        for (int db = 0; db < 4; ++db)
#pragma unroll
            for (int i = 0; i < 16; ++i) ex[(db * 16 + i) * 64] = o[db][i] * inv;
    }
    __syncthreads();
    if (kset == 0) {
        const float lam = lamp[0], lam_init = (layer_i == 0) ? 0.2f : 0.35550906759f;
        float ss = 0.f;
#pragma unroll
        for (int db = 0; db < 4; ++db)
#pragma unroll
            for (int i = 0; i < 16; ++i) { const float v = o[db][i] * inv - lam * ex[(db * 16 + i) * 64]; o[db][i] = v; ss += v * v; }
        ss = swapsum(ss);
        const float rs = (1.0f / sqrtf(ss * (1.f / 128.f) + EPSN)) * (1.f - lam_init);
        bf16_t* yrow = Ymix + (size_t)(qrow0 + r) * 512 + h * 128 + 4 * hi;
#pragma unroll
        for (int db = 0; db < 4; ++db)
#pragma unroll
            for (int g = 0; g < 4; ++g) { const int d = 32 * db + 8 * g; bf16_t* yp = yrow + d; const u32x2 gt = *(const u32x2*)yp; const f32x4 sl = *(const f32x4*)(subln + d + 4 * hi);
                u32x2 ov; ov.x = cvtpk(o[db][4 * g] * rs * sl.x * bflo(gt.x), o[db][4 * g + 1] * rs * sl.y * bfhi(gt.x));
                ov.y = cvtpk(o[db][4 * g + 2] * rs * sl.z * bflo(gt.y), o[db][4 * g + 3] * rs * sl.w * bfhi(gt.y));
                *(u32x2*)yp = ov; }
    }
    __syncthreads();
}

DI void attn_phase(LAS unsigned char* lds, const Params& P, int layer, int v, int G, bool dry, int tid) {
    unsigned char* ws = P.ws;
    const bf16_t* Pqk = (const bf16_t*)(ws + WS_PQK); const bf16_t* Vt = (const bf16_t*)(ws + WS_VT); bf16_t* Y = (bf16_t*)(ws + WS_Y);
    const f32x2_t* rope = (const f32x2_t*)(ws + WS_ROPE);
    const int nu = 512 + (layer == 0 ? 16 : 0);
#define ATT_DECODE(i, NH, NQB) int b_, h_, qb_; bool ic_ = false; if ((i) < 512) { b_ = (i) >> 8; h_ = ((i) / (NQB)) % (NH); qb_ = (i) % (NQB); } \
        else { const int k_ = (i) - 512; ic_ = true; b_ = k_ >> 3; if ((NH) == 4) { h_ = (k_ & 7) >> 1; qb_ = k_ & 1; } else { h_ = k_ & 7; qb_ = 0; } }
#if !defined(ATT_ONLY) || ATT_ONLY == 3
    { const float mfix = fmaxf(0.f, ((const float*)(ws + WS_LAM))[4 + layer * 4 + 3] - 100.0f); bf16_t* Ym = Y + (size_t)3 * MT * 512; const float* gq = P.qk_gain + layer * 512 + 3 * 128;
      if (mfix == 0.f) { for (int i = v; i < nu; i += G) { ATT_DECODE(i, 4, 64);
        attn_unit_d2(lds, Pqk, Vt, Ym, b_, h_, qb_, ic_, tid, gq, rope, (const float*)(ws + WS_LAM) + layer, layer, P.subln_d + layer * 128); } }
      else { for (int i = v; i < nu; i += G) { ATT_DECODE(i, 4, 64);
        attn_unit<3, false>(lds, Pqk, Vt, Ym, b_, h_, qb_, ic_, 0.f, nullptr, (const float*)(ws + WS_LAM) + layer, layer, P.subln_d + layer * 128, dry, 0.f, tid, gq, rope); } } }
#endif
#if !defined(ATT_ONLY) || ATT_ONLY == 2
    { const float mfix = fmaxf(0.f, ((const float*)(ws + WS_LAM))[4 + layer * 4 + 2] - 100.0f); bf16_t* Ym = Y + (size_t)2 * MT * 512; const float* gq = P.qk_gain + layer * 512 + 2 * 128;
      if (mfix == 0.f) { const int nu2 = 256 + (layer == 0 ? 8 : 0);
        for (int i = (v + 32) % G; i < nu2; i += G) { int b_, hp_, qb_; bool ic_ = false; if (i < 256) { b_ = i >> 7; hp_ = (i >> 5) & 3; qb_ = i & 31; } else { const int k_ = i - 256; ic_ = true; b_ = k_ >> 2; hp_ = k_ & 3; qb_ = 0; }
          attn_unit_c2(lds, Pqk, Vt, Ym, b_, hp_, qb_, ic_, dry, tid, gq, rope); } }
      else { for (int i = (v + 32) % G; i < nu; i += G) { ATT_DECODE(i, 8, 32);
        attn_unit<2, false>(lds, Pqk, Vt, Ym, b_, h_, qb_, ic_, 0.f, nullptr, nullptr, 0, nullptr, dry, 0.f, tid, gq, rope); } } }
#endif
#if !defined(ATT_ONLY) || ATT_ONLY == 0
    { bf16_t* Ym = Y; const float* gq = P.qk_gain + layer * 512;
      for (int i = (v + 64) % G; i < nu; i += G) { ATT_DECODE(i, 8, 32);
        attn_unit<0, false>(lds, Pqk, Vt, Ym, b_, h_, qb_, ic_, P.sink_a[layer * 8 + h_] * LOG2E, nullptr, nullptr, 0, nullptr, dry, 0.f, tid, gq, rope); } }
#endif
#if !defined(ATT_ONLY) || ATT_ONLY == 1
    { bf16_t* Ym = Y + (size_t)1 * MT * 512; const float* gq = P.qk_gain + layer * 512 + 1 * 128;
      for (int i = (v + 96) % G; i < nu; i += G) { ATT_DECODE(i, 8, 32);
        attn_unit<1, false>(lds, Pqk, Vt, Ym, b_, h_, qb_, ic_, 0.f, P.rpb_b + (size_t)(layer * 8 + h_) * 465, nullptr, 0, nullptr, dry, 0.f, tid, gq, rope); } }
#endif
#undef ATT_DECODE
}

#define XB_TMO      128
#define XB_XCNT(j)  (256  + 64 * (j))
#define XB_XSUB(j)  (1280 + 64 * (j))
#define XB_XGEN(j)  (2304 + 64 * (j))
#define XB_TOP      3328
#define XB_TOPGEN   3392
#define XCD_BAR_WORDS 3456
#define XB_SPIN_CAP (1u << 18)

__device__ __forceinline__ unsigned xb_ld(unsigned* p)              { return __hip_atomic_load(p, __ATOMIC_RELAXED, __HIP_MEMORY_SCOPE_AGENT); }
__device__ __forceinline__ unsigned xb_add(unsigned* p, unsigned v) { return __hip_atomic_fetch_add(p, v, __ATOMIC_RELAXED, __HIP_MEMORY_SCOPE_AGENT); }
__device__ __forceinline__ unsigned xb_xcc_id() { return (unsigned)__builtin_amdgcn_s_getreg((3 << 11) | 20) & 0xFu; }
#define XB_SPIN(cond, bar) do { unsigned _sp = 0; while (cond) { __builtin_amdgcn_s_sleep(1); \
    if ((++_sp & 255u) == 0u) { if (xb_ld(&(bar)[XB_TMO])) break; if (_sp > XB_SPIN_CAP) { atomicAdd(&(bar)[XB_TMO], 1u); break; } } } } while (0)

struct XcdBarrier {
    unsigned* bar; unsigned x;
    volatile LAS unsigned* st;
};

__device__ __forceinline__ XcdBarrier xcd_barrier_post(unsigned* bar, volatile LAS unsigned* st, int tid) {
    XcdBarrier b; b.bar = bar; b.x = xb_xcc_id(); b.st = st;
    if (tid == 0) (void)xb_add(&bar[XB_XCNT(b.x)], 1u);
    return b;
}
__device__ __forceinline__ void xcd_barrier_complete(unsigned* bar, unsigned x, unsigned& nloc, unsigned& nx) {
    const unsigned G = gridDim.x * gridDim.y * gridDim.z;
    unsigned sum, cnt, mine, sp = 0u;
    for (;;) {
        sum = 0u; cnt = 0u; mine = 0u;
#pragma unroll
        for (unsigned j = 0; j < 16; ++j) { const unsigned c = xb_ld(&bar[XB_XCNT(j)]); sum += c; cnt += (c > 0u) ? 1u : 0u; mine = (j == x) ? c : mine; }
        if (sum == G) break;
        __builtin_amdgcn_s_sleep(1);
        if ((++sp & 255u) == 0u) { if (xb_ld(&bar[XB_TMO])) break; if (sp > XB_SPIN_CAP) { atomicAdd(&bar[XB_TMO], 1u); break; } }
    }
    nloc = mine > 0u ? mine : 1u; nx = cnt > 0u ? cnt : 1u;
}

__device__ __forceinline__ void xcd_barrier(const XcdBarrier& b, int tid) {
    asm volatile("s_waitcnt vmcnt(0)" ::: "memory");
    __syncthreads();
    if (tid == 0) {
        unsigned* bar = b.bar;
        __builtin_amdgcn_s_waitcnt(0);
        unsigned nloc = b.st[0], nx = b.st[1];
        if (nloc == 0u) { xcd_barrier_complete(bar, b.x, nloc, nx); b.st[0] = nloc; b.st[1] = nx; }
        const unsigned old = xb_add(&bar[XB_XSUB(b.x)], 1u);
        const unsigned gen = old / nloc;
        if (old + 1u == (gen + 1u) * nloc) {
            __builtin_amdgcn_fence(__ATOMIC_RELEASE, "agent");
            asm volatile("s_waitcnt vmcnt(0)" ::: "memory");
            const unsigned og = xb_add(&bar[XB_TOP], 1u);
            const unsigned tg = og / nx;
            if (og + 1u == (tg + 1u) * nx) xb_add(&bar[XB_TOPGEN], 1u);
            else XB_SPIN(xb_ld(&bar[XB_TOPGEN]) == tg, bar);
            __builtin_amdgcn_fence(__ATOMIC_ACQUIRE, "agent");
            xb_add(&bar[XB_XGEN(b.x)], 1u);
            asm volatile("s_waitcnt vmcnt(0)" ::: "memory");
        } else {
            XB_SPIN(xb_ld(&bar[XB_XGEN(b.x)]) == gen, bar);
            __builtin_amdgcn_fence(__ATOMIC_ACQUIRE, "agent");
            asm volatile("s_waitcnt vmcnt(0)" ::: "memory");
        }
    }
    __syncthreads();
}

constexpr int NPHASE = 15;
__global__ void __launch_bounds__(NTHREADS, 2) dit_fwd(Params P0) {
    extern __shared__ __attribute__((aligned(16))) unsigned char lds_raw[];
    LAS unsigned char* lds = (LAS unsigned char*)lds_raw;
    cg::grid_group grid = cg::this_grid();
    const int G = gridDim.x;
    const int ph_lo = P0.ph_lo, ph_hi = P0.ph_hi;
    const int wave0 = __builtin_amdgcn_readfirstlane((int)threadIdx.x >> 6);
    { const int t0 = wave0 * 64 + (int)__builtin_amdgcn_mbcnt_hi(~0u, __builtin_amdgcn_mbcnt_lo(~0u, 0u)); if (t0 < 2) ((volatile LAS unsigned*)(lds + LDS_MISC))[t0] = 0u; }
    __syncthreads();
    if (ph_hi > 1000) grid.sync();
    XcdBarrier bar = xcd_barrier_post((unsigned*)(P0.ws + WS_BAR), (volatile LAS unsigned*)(lds + LDS_MISC), wave0 * 64 + (int)__builtin_amdgcn_mbcnt_hi(~0u, __builtin_amdgcn_mbcnt_lo(~0u, 0u)));
    for (int ph = ph_lo; ph < ph_hi; ++ph) {
        int wv_op = wave0, bid_op = blockIdx.x; asm volatile("" : "+s"(wv_op), "+s"(bid_op));
        unsigned all1 = ~0u; asm volatile("" : "+s"(all1));
        int tid_op = wv_op * 64 + (int)__builtin_amdgcn_mbcnt_hi(all1, __builtin_amdgcn_mbcnt_lo(all1, 0u)); asm volatile("" : "+v"(tid_op));
        if (ph > ph_lo) xcd_barrier(bar, tid_op);
        typedef const Params __attribute__((address_space(4)))* KArgPtr;
        KArgPtr pp = (KArgPtr)__builtin_amdgcn_kernarg_segment_ptr(); asm volatile("" : "+s"(pp));
        Params P; P.x = pp->x; P.c = pp->c; P.ctx = pp->ctx; P.c_ctx = pp->c_ctx; P.norm_w = pp->norm_w; P.w_ada = pp->w_ada; P.b_ada = pp->b_ada; P.w_in = pp->w_in; P.qk_gain = pp->qk_gain;
        P.sink_a = pp->sink_a; P.rpb_b = pp->rpb_b; P.lam_d = pp->lam_d; P.subln_d = pp->subln_d; P.w_br = pp->w_br; P.w_out = pp->w_out; P.out = pp->out; P.ws = pp->ws; P.ph_lo = 0; P.ph_hi = 0;
        unsigned char* ws = P.ws;
        const int tid = tid_op, bid = bid_op, wave = __builtin_amdgcn_readfirstlane(tid >> 6);
        const int vcu = (G % 8 == 0) ? (bid % 8) * (G / 8) + bid / 8 : bid;
        const int gw = bid * NWAVES + wave, NGW = G * NWAVES;
        const int layer = (ph - 1) / 7, sub = (ph - 1) % 7;
        const float* modl = (const float*)(ws + WS_MOD) + layer * 3 * 3072;
        const float* xcur = (layer == 0) ? P.x : P.out; const float* ccur = (layer == 0) ? P.ctx : (const float*)(ws + WS_CTX1);
        bf16_t* H = (bf16_t*)(ws + WS_H);
        bf16_t* WinT = (bf16_t*)(ws + WS_WIN) + (size_t)layer * NINC * DM;
        const int Ml = (layer == 0) ? MT : MX;
        if (ph == 0) {
#ifndef NO_PRO
            prologue_phase(P, lds, bid, G, tid, (tid & 63), wave);
#ifdef PROBE_MISC
            __syncthreads(); prologue_phase(P, lds, bid, G, tid, (tid & 63), wave);
#endif
#endif
        } else if (sub == 0) {
#ifndef NO_NORM
            norm_phase(xcur, ccur, P.norm_w + layer * DM, modl, H, gw, NGW, (tid & 63));
#ifdef PROBE_MISC
            norm_phase(xcur, ccur, P.norm_w + layer * DM, modl, H, gw, NGW, (tid & 63));
#endif
#endif
        } else if (sub == 2) {
#ifndef NO_PREP
#ifdef PROBE_MISC
            prep_phase((bf16_t*)(ws + WS_PQK), P.qk_gain + layer * 512, (const f32x2_t*)(ws + WS_ROPE), gw, NGW, (tid & 63), ph_hi < 100);
#endif
            prep_phase((bf16_t*)(ws + WS_PQK), P.qk_gain + layer * 512, (const f32x2_t*)(ws + WS_ROPE), gw, NGW, (tid & 63), false);
#endif
        } else if (sub == 3) {
#ifndef NO_ATT
#ifdef PROBE_ATT
            attn_phase(lds, P, layer, vcu, G, ph_hi < 100, tid);
            __syncthreads();
#endif
            attn_phase(lds, P, layer, vcu, G, false, tid);
#endif
        } else if (sub == 1 || sub == 4) {
#if !defined(GEMM_ONLY) || GEMM_ONLY == 1
            if (sub == 1) {
                pg8::Gemm g; EpiAct E; g.K = DM; g.A = H; g.Bt = WinT; g.M = MT; g.N = R_G;
                E.mode = 0; E.O = (bf16_t*)(ws + WS_PQK); E.ldc = NQK; E.act = 0; E.Y = (bf16_t*)(ws + WS_Y); E.VT = (bf16_t*)(ws + WS_VT);
                InProjOrder S; S.init(G, bid, layer); E.offa = S.offa; E.offb = S.offb;
#ifdef PROBE_GEMM
                for (int rep = 0; rep < 2; ++rep)
#endif
                pg8::gemm_phase<EpiAct, InProjOrder, true, true, 1024>(lds, g, S, E, tid);
            } else {
                pg8::Gemm g; EpiAct E; g.K = DM; g.A = H; g.Bt = WinT + (size_t)R_G * DM; g.M = Ml; g.N = 4096;
                E.mode = 1; E.O = (bf16_t*)(ws + WS_G); E.ldc = 4096; E.act = 2; E.Y = nullptr; E.VT = nullptr; E.offa = 0; E.offb = 0;
                pg8::StaticOrder S; S.init(g.M, g.N, G, bid);
                pg8::gemm_phase<EpiAct, pg8::StaticOrder, true, true, 1024>(lds, g, S, E, tid);
            }
#endif
        } else if (sub == 5) {
#if !defined(GEMM_ONLY) || GEMM_ONLY == 5
            pg8::Gemm g; g.A = (bf16_t*)(ws + WS_Y); g.Bt = (bf16_t*)(ws + WS_WBR) + (size_t)(layer * 4) * 1024 * 512; g.M = Ml; g.N = DM; g.K = 512;
            EpiMerge E; E.O = H; E.G0 = (const bf16_t*)(ws + WS_G);
            MergeOrder S; S.init(g.M, G, bid);
            pg8::gemm_phase<EpiMerge, MergeOrder, true, true, 512>(lds, g, S, E, tid);
#endif
        } else {
#if !defined(GEMM_ONLY) || GEMM_ONLY == 6
            pg8::Gemm g; g.A = H; g.Bt = (bf16_t*)(ws + WS_WOUT) + (size_t)layer * DM * DM; g.M = Ml; g.N = DM; g.K = DM;
            EpiOut E; E.xres = xcur; E.xout = P.out; E.cres = ccur; E.cout = (float*)(ws + WS_CTX1); E.modl = modl;
            pg8::StaticOrder S; S.init(g.M, g.N, G, bid);
            pg8::gemm_phase<EpiOut, pg8::StaticOrder, true, true, 1024>(lds, g, S, E, tid);
#endif
        }
    }
}

extern "C" void kernel_launch(void* const* d_in, const int* in_sizes, int n_in, void* d_out, int out_size, void* d_ws, size_t ws_size, hipStream_t stream) {
    static int grid = 0;
    if (grid == 0) {
        if (n_in != 15 || out_size != MX * DM || ws_size < WS_END) { fprintf(stderr, "kernel_launch: unexpected shapes (n_in %d out %d ws %zu, need %zu)\n", n_in, out_size, ws_size, (size_t)WS_END); grid = -1; return; }
        int dev = 0, cus = 0, per_cu = 0;
        hipGetDevice(&dev); hipDeviceGetAttribute(&cus, hipDeviceAttributeMultiprocessorCount, dev);
        if (hipFuncSetAttribute((const void*)dit_fwd, hipFuncAttributeMaxDynamicSharedMemorySize, LDS_BYTES) != hipSuccess) { fprintf(stderr, "kernel_launch: hipFuncSetAttribute failed\n"); grid = -1; return; }
        if (hipOccupancyMaxActiveBlocksPerMultiprocessor(&per_cu, (const void*)dit_fwd, NTHREADS, LDS_BYTES) != hipSuccess || per_cu < 1) { fprintf(stderr, "kernel_launch: occupancy query failed (%d)\n", per_cu); (void)hipGetLastError(); grid = -1; return; }
        grid = cus * 1;
    }
    if (grid < 0) return;
    Params p{};
    p.x = (const float*)d_in[0]; p.c = (const float*)d_in[1]; p.ctx = (const float*)d_in[2]; p.c_ctx = (const float*)d_in[3]; p.norm_w = (const float*)d_in[4];
    p.w_ada = (const float*)d_in[5]; p.b_ada = (const float*)d_in[6]; p.w_in = (const float*)d_in[7]; p.qk_gain = (const float*)d_in[8]; p.sink_a = (const float*)d_in[9];
    p.rpb_b = (const float*)d_in[10]; p.lam_d = (const float*)d_in[11]; p.subln_d = (const float*)d_in[12]; p.w_br = (const float*)d_in[13]; p.w_out = (const float*)d_in[14];
    p.out = (float*)d_out; p.ws = (unsigned char*)d_ws;
    if (hipMemsetAsync((char*)d_ws + WS_BAR, 0, 16384, stream) != hipSuccess) { fprintf(stderr, "kernel_launch: memset failed\n"); return; }
#ifdef MULTI_LAUNCH
    for (int ph = 0; ph < NPHASE; ++ph) { p.ph_lo = ph; p.ph_hi = ph + 1; hipLaunchKernelGGL(dit_fwd, dim3(grid), dim3(NTHREADS), LDS_BYTES, stream, p); }
#else
    p.ph_lo = 0; p.ph_hi = NPHASE;
    void* args[] = {&p};
    hipError_t e = hipLaunchCooperativeKernel((const void*)dit_fwd, dim3(grid), dim3(NTHREADS), args, LDS_BYTES, stream);
    if (e != hipSuccess) fprintf(stderr, "kernel_launch: cooperative launch failed: %s (grid %d)\n", hipGetErrorString(e), grid);
#endif
}
```

```cpp
#include <hip/hip_runtime.h>
#include <hip/hip_cooperative_groups.h>
#include <cstdio>
#include <cstdint>
namespace cg = cooperative_groups;
namespace pg8 {
#define PG8_LAS __attribute__((address_space(3)))
typedef unsigned short bf16_t;
typedef short bf16x8 __attribute__((ext_vector_type(8)));
typedef float f32x4 __attribute__((ext_vector_type(4)));
typedef unsigned u32x4 __attribute__((ext_vector_type(4)));
constexpr int BM = 256, BK = 64, HALF = 128, HTB = HALF * BK * 2  , STAGE_BYTES = 8 * HTB, NXCD = 8, WGM = 8;

__host__ __device__ __forceinline__ int lds_byte(int r, int c) { const int st = (r >> 4) * 2 + (c >> 5), rr = r & 15, cc = c & 31, ob = rr * 64 + cc * 2; return st * 1024 + (ob ^ (((ob >> 9) & 1) << 5)); }
__host__ __device__ __forceinline__ void stage_rc(int b, int& R, int& C) { const int st = b / 1024, sb = b % 1024, swz = sb ^ (((sb >> 9) & 1) << 5); R = (st >> 1) * 16 + swz / 64; C = (st & 1) * 32 + (swz % 64) / 2; }
__host__ __device__ __forceinline__ int perm32(int rho) { const int n = rho >> 4, i = rho & 15; return 8 * (i >> 2) + 4 * n + (i & 3); }

struct Unit { int pm, pn; };
struct Gemm { const bf16_t* A; const bf16_t* Bt; int M, N, K; };

struct StaticOrder {
    int nM, nN, nwg, G, c;
    __host__ __device__ void init(int M, int N, int G_, int c_) { nM = M / BM; nN = N / BM; nwg = nM * nN; G = G_; c = c_; }
    __host__ __device__ bool next(int i, Unit& u) const {
        const long L = (long)i * G + c; if (L >= nwg) return false;
        int wgid = (int)L; { const int q = nwg / NXCD, r = nwg % NXCD, xcd = wgid % NXCD, off = wgid / NXCD; wgid = (xcd < r ? xcd * (q + 1) : r * (q + 1) + (xcd - r) * q) + off; }
        const int nig = WGM * nN, gid = wgid / nig, fm = gid * WGM, gsz = (nM - fm) < WGM ? (nM - fm) : WGM;
        u.pm = fm + ((wgid % nig) % gsz); u.pn = (wgid % nig) / gsz; return true;
    }
    __device__ __forceinline__ void a_ready(const Unit&) const {}
    __device__ __forceinline__ void done(const Unit&) const {}
};

__device__ __forceinline__ unsigned cvt_pk_bf16(float lo, float hi) { unsigned r; asm volatile("v_cvt_pk_bf16_f32 %0, %1, %2" : "=v"(r) : "v"(lo), "v"(hi)); return r; }
template <class Epi, class Sched, bool ALIGN_EPI = false, bool SP2 = false, int KC = 0>
__device__ __forceinline__ void gemm_phase(PG8_LAS unsigned char* lds, const Gemm g, const Sched& S, const Epi& E, int tid_in) {
    int tid_op = tid_in; asm volatile("" : "+v"(tid_op));
    const int tid = tid_op, wid = __builtin_amdgcn_readfirstlane(tid >> 6), lane = tid & 63, wr = wid >> 2, wc = wid & 3, fr = lane & 15, fq = lane >> 4;
    const int K = KC ? KC : g.K, nt = K / BK;
    unsigned voffA[2], voffB[2];
#pragma unroll
    for (int i = 0; i < 2; ++i) { int R, C; stage_rc(tid * 16 + i * 8192, R, C); const int Rb = Epi::PERM ? ((R & ~31) + perm32(R & 31)) : R;
        voffA[i] = (unsigned)(R * K + C) * 2u; voffB[i] = (unsigned)(Rb * K + C) * 2u; }
    const size_t kstep = (size_t)(BK * 2);
    const size_t hstep = (size_t)HALF * K * 2;
    const size_t tstep = 2 * hstep;
    const unsigned ldsw = (unsigned)wid * 1024u;
    const int aoff = lds_byte(wr * 64 + fr, fq * 8), boff = lds_byte(wc * 32 + fr, fq * 8);
#define PG8_SA(b, h) (((b) * 2 + (h)) * HTB)
#define PG8_SB(b, h) ((4 + (b) * 2 + (h)) * HTB)
#define PG8_STAGE(bufoff, gbase, voff) do { _Pragma("unroll") for (int _i = 0; _i < 2; ++_i) \
        __builtin_amdgcn_global_load_lds((const unsigned*)((const char*)(gbase) + (voff)[_i]), (PG8_LAS unsigned*)(lds + (bufoff) + ldsw + _i * 8192), 16, 0, 0); } while (0)
#define PG8_LDA(dst, b, h) do { _Pragma("unroll") for (int m = 0; m < 4; ++m) _Pragma("unroll") for (int k = 0; k < 2; ++k) dst[m][k] = *(const PG8_LAS bf16x8*)(lds + PG8_SA(b, h) + aoff + m * 2048 + k * 1024); } while (0)
#define PG8_LDB(dst, b, h) do { _Pragma("unroll") for (int n = 0; n < 2; ++n) _Pragma("unroll") for (int k = 0; k < 2; ++k) dst[n][k] = *(const PG8_LAS bf16x8*)(lds + PG8_SB(b, h) + boff + n * 2048 + k * 1024); } while (0)
#define PG8_MMA(ai, bj, At, Bt) do { __builtin_amdgcn_s_setprio(1); _Pragma("unroll") for (int m = 0; m < 4; ++m) _Pragma("unroll") for (int n = 0; n < 2; ++n) _Pragma("unroll") for (int k = 0; k < 2; ++k) \
        acc[ai][bj][m][n] = __builtin_amdgcn_mfma_f32_16x16x32_bf16(Bt[n][k], At[m][k], acc[ai][bj][m][n], 0, 0, 0); __builtin_amdgcn_s_setprio(0); } while (0)
#define PG8_WAIT_V(n) asm volatile("s_waitcnt vmcnt(" #n ")" ::: "memory")
#define PG8_WAIT_L(n) asm volatile("s_waitcnt lgkmcnt(" #n ")" ::: "memory")
#define PG8_BAR __builtin_amdgcn_s_barrier()
#define PG8_SCHED __builtin_amdgcn_sched_barrier(0)
    Unit cur, nxt; int ui = 0;
    if (!S.next(0, cur)) return;
    f32x4 acc[2][2][4][2];
#pragma unroll
    for (int a = 0; a < 2; ++a)
#pragma unroll
        for (int b = 0; b < 2; ++b)
#pragma unroll
            for (int m = 0; m < 4; ++m)
#pragma unroll
                for (int n = 0; n < 2; ++n) acc[a][b][m][n] = (f32x4){0.f, 0.f, 0.f, 0.f};
    bf16x8 At[4][2], B0[2][2], B1[2][2];
    const char* cA = (const char*)g.A + (size_t)cur.pm * tstep; const char* cB = (const char*)g.Bt + (size_t)cur.pn * tstep;
    S.a_ready(cur);
    if constexpr (SP2) {
        PG8_STAGE(PG8_SB(0, 0), cB, voffB); PG8_STAGE(PG8_SB(0, 1), cB + hstep, voffB); PG8_STAGE(PG8_SA(0, 0), cA, voffA); PG8_STAGE(PG8_SA(0, 1), cA + hstep, voffA);
        if (wr == 1) PG8_BAR;
        PG8_WAIT_V(2); PG8_BAR;
        PG8_STAGE(PG8_SB(1, 0), cB + kstep, voffB); PG8_STAGE(PG8_SA(1, 0), cA + kstep, voffA); PG8_STAGE(PG8_SB(1, 1), cB + hstep + kstep, voffB);
        PG8_WAIT_V(6); PG8_BAR;
    } else {
        PG8_STAGE(PG8_SB(0, 0), cB, voffB); PG8_STAGE(PG8_SA(0, 0), cA, voffA); PG8_STAGE(PG8_SB(0, 1), cB + hstep, voffB); PG8_STAGE(PG8_SA(0, 1), cA + hstep, voffA);
        if (wr == 1) PG8_BAR;
        PG8_WAIT_V(4); PG8_BAR;
        PG8_STAGE(PG8_SB(1, 0), cB + kstep, voffB); PG8_STAGE(PG8_SA(1, 0), cA + kstep, voffA); PG8_STAGE(PG8_SB(1, 1), cB + hstep + kstep, voffB);
        PG8_WAIT_V(6); PG8_BAR;
    }
    for (;;) {
        const bool has_next = S.next(ui + 1, nxt);
        const char* nA = has_next ? (const char*)g.A + (size_t)nxt.pm * tstep : cA; const char* nB = has_next ? (const char*)g.Bt + (size_t)nxt.pn * tstep : cB;
        for (int t = 0; t < nt; t += 2) {
            const bool last = (t == nt - 2);
            const char* a1 = cA + (size_t)(t + 1) * kstep;
            const char* a2 = last ? nA : cA + (size_t)(t + 2) * kstep; const char* b2 = last ? nB : cB + (size_t)(t + 2) * kstep;
            const char* a3 = a2 + kstep; const char* b3 = b2 + kstep;
            if (last && has_next) S.a_ready(nxt);
            if constexpr (SP2) {
            PG8_LDB(B0, 0, 0); PG8_LDB(B1, 0, 1); PG8_SCHED; PG8_LDA(At, 0, 0); PG8_STAGE(PG8_SA(1, 1), a1 + hstep, voffA);
            PG8_WAIT_V(8); PG8_WAIT_L(0); PG8_BAR; PG8_MMA(0, 0, At, B0); PG8_MMA(0, 1, At, B1); PG8_BAR; PG8_SCHED;
            PG8_LDA(At, 0, 1); PG8_STAGE(PG8_SB(0, 0), b2, voffB); PG8_STAGE(PG8_SB(0, 1), b2 + hstep, voffB); PG8_STAGE(PG8_SA(0, 0), a2, voffA);
            PG8_WAIT_V(8); PG8_WAIT_L(0); PG8_BAR; PG8_MMA(1, 0, At, B0); PG8_MMA(1, 1, At, B1); PG8_BAR; PG8_SCHED;
            PG8_LDB(B0, 1, 0); PG8_LDB(B1, 1, 1); PG8_SCHED; PG8_LDA(At, 1, 0); PG8_STAGE(PG8_SA(0, 1), a2 + hstep, voffA);
            PG8_WAIT_V(8); PG8_WAIT_L(0); PG8_BAR; PG8_MMA(0, 0, At, B0); PG8_MMA(0, 1, At, B1); PG8_BAR; PG8_SCHED;
            PG8_LDA(At, 1, 1); PG8_STAGE(PG8_SB(1, 0), b3, voffB); PG8_STAGE(PG8_SB(1, 1), b3 + hstep, voffB); PG8_STAGE(PG8_SA(1, 0), a3, voffA);
            PG8_WAIT_V(8); PG8_WAIT_L(0); PG8_BAR; PG8_MMA(1, 0, At, B0); PG8_MMA(1, 1, At, B1); PG8_BAR; PG8_SCHED;
            } else {
            PG8_LDB(B0, 0, 0); PG8_SCHED; PG8_LDA(At, 0, 0); PG8_STAGE(PG8_SA(1, 1), a1 + hstep, voffA);
            PG8_WAIT_L(8); PG8_BAR; PG8_WAIT_L(0); PG8_MMA(0, 0, At, B0); PG8_BAR; PG8_SCHED;
            PG8_LDB(B1, 0, 1); PG8_STAGE(PG8_SB(0, 0), b2, voffB);
            PG8_BAR; PG8_WAIT_L(0); PG8_MMA(0, 1, At, B1); PG8_BAR;
            PG8_LDA(At, 0, 1); PG8_STAGE(PG8_SA(0, 0), a2, voffA);
            PG8_BAR; PG8_WAIT_L(0); PG8_MMA(1, 0, At, B0); PG8_BAR; PG8_SCHED;
            PG8_STAGE(PG8_SB(0, 1), b2 + hstep, voffB);
            PG8_WAIT_V(6); PG8_BAR; PG8_MMA(1, 1, At, B1); PG8_BAR;
            PG8_LDB(B0, 1, 0); PG8_SCHED; PG8_LDA(At, 1, 0); PG8_STAGE(PG8_SA(0, 1), a2 + hstep, voffA);
            PG8_WAIT_L(8); PG8_BAR; PG8_WAIT_L(0); PG8_MMA(0, 0, At, B0); PG8_BAR; PG8_SCHED;
            PG8_LDB(B1, 1, 1); PG8_STAGE(PG8_SB(1, 0), b3, voffB);
            PG8_BAR; PG8_WAIT_L(0); PG8_MMA(0, 1, At, B1); PG8_BAR;
            PG8_LDA(At, 1, 1); PG8_STAGE(PG8_SA(1, 0), a3, voffA);
            PG8_BAR; PG8_WAIT_L(0); PG8_MMA(1, 0, At, B0); PG8_BAR; PG8_SCHED;
            PG8_STAGE(PG8_SB(1, 1), b3 + hstep, voffB);
            PG8_WAIT_V(6); PG8_BAR; PG8_MMA(1, 1, At, B1); PG8_BAR;
            }
        }
        if constexpr (ALIGN_EPI) { if (wr == 0) PG8_BAR; }
        if constexpr (!Epi::AFTER_DRAIN) { E(acc, cur, wr, wc, fr, fq); S.done(cur); }
        if (!has_next) break;
#pragma unroll
        for (int a = 0; a < 2; ++a)
#pragma unroll
            for (int b = 0; b < 2; ++b)
#pragma unroll
                for (int m = 0; m < 4; ++m)
#pragma unroll
                    for (int n = 0; n < 2; ++n) acc[a][b][m][n] = (f32x4){0.f, 0.f, 0.f, 0.f};
        cur = nxt; cA = nA; cB = nB; ++ui;
        if constexpr (ALIGN_EPI) { if (wr == 1) PG8_BAR; }
    }
    PG8_WAIT_V(0);
    if constexpr (!ALIGN_EPI) { if (wr == 0) PG8_BAR; }
    PG8_BAR;
    if constexpr (Epi::AFTER_DRAIN) { E.fused(acc, cur, wr, wc, fr, fq, lds, wid, lane); S.done(cur); }
#undef PG8_SA
#undef PG8_SB
#undef PG8_STAGE
#undef PG8_LDA
#undef PG8_LDB
#undef PG8_MMA
#undef PG8_WAIT_V
#undef PG8_WAIT_L
#undef PG8_BAR
#undef PG8_SCHED
}
}
using pg8::bf16_t; using pg8::bf16x8; using pg8::f32x4; using pg8::u32x4;
#define LAS __attribute__((address_space(3)))
#define DI __device__ __forceinline__
typedef short s16x4 __attribute__((ext_vector_type(4)));
typedef float f32x16 __attribute__((ext_vector_type(16)));
typedef float f32x2_t __attribute__((ext_vector_type(2)));
typedef __bf16 bf16x2_t __attribute__((ext_vector_type(2)));
typedef unsigned u32x2 __attribute__((ext_vector_type(2)));

constexpr int DM = 1024, SEQ = 8192, NBATCH = 2, CTXL = 256;
constexpr int MX = NBATCH * SEQ, MT = MX + NBATCH * CTXL;
constexpr int NQK = 3328, NV = 1280, NINC = 10752;
constexpr int R_PG = 3328, R_G = 5376, R_V = 9472;
constexpr float LOG2E = 1.4426950408889634f, QSCALE = 0.125f * LOG2E, EPSN = 1e-6f;
constexpr int NTHREADS = 512, NWAVES = 8, LDS_BYTES = 131072 + 256, LDS_MISC = 131072;

constexpr size_t MiB = 1u << 20;
constexpr size_t WS_MOD = 0;
constexpr size_t WS_ROPE = 128 * 1024;
constexpr size_t WS_LAM = 256 * 1024;
constexpr size_t WS_BAR = 512 * 1024;
constexpr size_t WS_CTX1 = 1 * MiB;
constexpr size_t WS_WIN = 4 * MiB;
constexpr size_t WS_WBR = 46 * MiB;
constexpr size_t WS_WOUT = 54 * MiB;
constexpr size_t WS_H = 58 * MiB;
constexpr size_t WS_Y = 91 * MiB;
constexpr size_t WS_PQK = 157 * MiB;
constexpr size_t WS_VT = WS_PQK + (size_t)MT * NQK * 2;
constexpr size_t WS_G = WS_PQK;
constexpr size_t WS_END = WS_VT + (size_t)NV * MT * 2;
static_assert(WS_WIN + (size_t)2 * NINC * DM * 2 <= WS_WBR && WS_H + (size_t)MT * DM * 2 <= WS_Y && WS_Y + (size_t)4 * MT * 512 * 2 <= WS_PQK && WS_G + (size_t)MT * 4096 * 2 <= WS_END, "d_ws map");

struct Params {
    const float *x, *c, *ctx, *c_ctx, *norm_w, *w_ada, *b_ada, *w_in, *qk_gain, *sink_a, *rpb_b, *lam_d, *subln_d, *w_br, *w_out;
    float* out; unsigned char* ws; int ph_lo, ph_hi;
};

DI unsigned cvtpk(float lo, float hi) { f32x2_t v = {lo, hi}; bf16x2_t b = __builtin_convertvector(v, bf16x2_t); return __builtin_bit_cast(unsigned, b); }
DI float bflo(unsigned u) { return __uint_as_float(u << 16); }
DI float bfhi(unsigned u) { return __uint_as_float(u & 0xffff0000u); }
DI float wave_sum(float v) {
#pragma unroll
    for (int o = 1; o < 64; o <<= 1) v += __shfl_xor(v, o);
    return v;
}
DI float fexp2(float x) { return __builtin_amdgcn_exp2f(x); }
DI float silu_f(float x) { return x * __builtin_amdgcn_rcpf(1.f + fexp2(-x * LOG2E)); }
DI float sigm_f(float x) { return __builtin_amdgcn_rcpf(1.f + fexp2(-x * LOG2E)); }

struct EpiAct {
    static constexpr bool PERM = true, AFTER_DRAIN = false;
    int mode, ldc, act; bf16_t* O; bf16_t* Y; bf16_t* VT; int offa, offb;
    DI void operator()(const f32x4 (&acc)[2][2][4][2], const pg8::Unit& u, int wr, int wc, int fr, int fq) const {
        int row0 = u.pm * 256 + wr * 64 + fr;
        bf16_t* base = O; int ld = ldc, colt = u.pn * 256, a = act;
        if (mode == 0) { a = 0; if (u.pn < 13) { ld = NQK; } else if (u.pn < 21) { const int g = u.pn - 13; base = Y + (size_t)(g >> 1) * MT * 512; ld = 512; colt = (g & 1) * 256; a = 1; }
            else { base = VT; ld = MT; colt = (u.pn - offb) * 256; row0 = (u.pm - offa) * 256 + wr * 64 + fr; } }
        const int col0 = colt + wc * 32 + 8 * fq;
#pragma unroll
        for (int ai = 0; ai < 2; ++ai)
#pragma unroll
            for (int m = 0; m < 4; ++m) { bf16_t* rowp = base + (size_t)(row0 + ai * 128 + m * 16) * ld + col0;
#pragma unroll
                for (int bj = 0; bj < 2; ++bj) { f32x4 v0 = acc[ai][bj][m][0], v1 = acc[ai][bj][m][1];
                    if (a == 1) {
#pragma unroll
                        for (int e = 0; e < 4; ++e) { v0[e] = silu_f(v0[e]); v1[e] = silu_f(v1[e]); } }
                    else if (a == 2) {
#pragma unroll
                        for (int e = 0; e < 4; ++e) { v0[e] = sigm_f(v0[e]); v1[e] = sigm_f(v1[e]); } }
                    u32x4 w; w.x = cvtpk(v0[0], v0[1]); w.y = cvtpk(v0[2], v0[3]); w.z = cvtpk(v1[0], v1[1]); w.w = cvtpk(v1[2], v1[3]);
                    *(u32x4*)(rowp + bj * 128) = w; } }
    }
};
struct EpiMerge {
    static constexpr bool PERM = true, AFTER_DRAIN = false;
    bf16_t* O; const bf16_t* G0;
    DI void operator()(const f32x4 (&acc)[2][2][4][2], const pg8::Unit& u, int wr, int wc, int fr, int fq) const {
        const int nbr = u.pn >> 2; const bool first = (nbr == 0); const bf16_t* G = G0 + nbr * 1024;
        const int row0 = (u.pm - 66 * nbr) * 256 + wr * 64 + fr;
        const int col0 = (u.pn & 3) * 256 + wc * 32 + 8 * fq;
#pragma unroll
        for (int ai = 0; ai < 2; ++ai) {
            u32x4 g[4][2], o[4][2];
#pragma unroll
            for (int m = 0; m < 4; ++m)
#pragma unroll
                for (int bj = 0; bj < 2; ++bj) { const size_t row = (size_t)(row0 + ai * 128 + m * 16); const int col = col0 + bj * 128;
                    g[m][bj] = *(const u32x4*)(G + row * 4096 + col);
                    if (!first) o[m][bj] = *(const u32x4*)(O + row * 1024 + col); else o[m][bj] = (u32x4){0u, 0u, 0u, 0u}; }
#pragma unroll
            for (int m = 0; m < 4; ++m)
#pragma unroll
                for (int bj = 0; bj < 2; ++bj) { const size_t row = (size_t)(row0 + ai * 128 + m * 16); const int col = col0 + bj * 128;
                    const u32x4 gg = g[m][bj], oo = o[m][bj];
                    f32x4 v0 = acc[ai][bj][m][0], v1 = acc[ai][bj][m][1];
                    v0[0] = v0[0] * bflo(gg.x) + bflo(oo.x); v0[1] = v0[1] * bfhi(gg.x) + bfhi(oo.x); v0[2] = v0[2] * bflo(gg.y) + bflo(oo.y); v0[3] = v0[3] * bfhi(gg.y) + bfhi(oo.y);
                    v1[0] = v1[0] * bflo(gg.z) + bflo(oo.z); v1[1] = v1[1] * bfhi(gg.z) + bfhi(oo.z); v1[2] = v1[2] * bflo(gg.w) + bflo(oo.w); v1[3] = v1[3] * bfhi(gg.w) + bfhi(oo.w);
                    u32x4 w; w.x = cvtpk(v0[0], v0[1]); w.y = cvtpk(v0[2], v0[3]); w.z = cvtpk(v1[0], v1[1]); w.w = cvtpk(v1[2], v1[3]);
                    *(u32x4*)(O + row * 1024 + col) = w; }
            asm volatile("" ::: "memory");
        }
    }
};
struct EpiOut {
    static constexpr bool PERM = true, AFTER_DRAIN = false;
    const float* xres; float* xout; const float* cres; float* cout; const float* modl;
    DI void operator()(const f32x4 (&acc)[2][2][4][2], const pg8::Unit& u, int wr, int wc, int fr, int fq) const {
        const int row0 = u.pm * 256 + wr * 64 + fr;
        const float* res; float* out; const float* gate; int rbase;
        if (u.pm < 64) { res = xres; out = xout; gate = modl + (u.pm >> 5) * 3072 + 2048; rbase = row0; }
        else { res = cres; out = cout; gate = modl + 2 * 3072 + 2048; rbase = row0 - MX; }
        const int col0 = u.pn * 256 + wc * 32 + 8 * fq;
#pragma unroll
        for (int bj = 0; bj < 2; ++bj)
#pragma unroll
            for (int n = 0; n < 2; ++n) { const int col = col0 + bj * 128 + 4 * n; const f32x4 gv = *(const f32x4*)(gate + col);
                f32x4 rv[2][4];
#pragma unroll
                for (int ai = 0; ai < 2; ++ai)
#pragma unroll
                    for (int m = 0; m < 4; ++m) rv[ai][m] = *(const f32x4*)(res + (size_t)(rbase + ai * 128 + m * 16) * 1024 + col);
#pragma unroll
                for (int ai = 0; ai < 2; ++ai)
#pragma unroll
                    for (int m = 0; m < 4; ++m) *(f32x4*)(out + (size_t)(rbase + ai * 128 + m * 16) * 1024 + col) = rv[ai][m] + gv * acc[ai][bj][m][n];
                asm volatile("" ::: "memory"); }
    }
};

struct PackedOrder {
    unsigned long long w0, w1, w2; int n;
    DI void init(int M, int N, int G, int c) {
        pg8::StaticOrder S; S.init(M, N, G, c); w0 = 0ull; w1 = 0ull; w2 = 0ull; n = 0;
#pragma unroll
        for (int i = 0; i < 12; ++i) { pg8::Unit u; const bool ok = S.next(i, u);
            if (ok) { const unsigned long long v = (unsigned long long)((u.pm << 8) | u.pn) << (16 * (i & 3)); if (i < 4) w0 |= v; else if (i < 8) w1 |= v; else w2 |= v; n = i + 1; } }
        w0 = __builtin_amdgcn_readfirstlane((unsigned)w0) | ((unsigned long long)__builtin_amdgcn_readfirstlane((unsigned)(w0 >> 32)) << 32);
        w1 = __builtin_amdgcn_readfirstlane((unsigned)w1) | ((unsigned long long)__builtin_amdgcn_readfirstlane((unsigned)(w1 >> 32)) << 32);
        w2 = __builtin_amdgcn_readfirstlane((unsigned)w2) | ((unsigned long long)__builtin_amdgcn_readfirstlane((unsigned)(w2 >> 32)) << 32);
        n = __builtin_amdgcn_readfirstlane(n);
    }
    DI bool next(int i, pg8::Unit& u) const {
        if (i >= n) return false;
        const unsigned long long x = (i < 4) ? w0 : (i < 8) ? w1 : w2; const unsigned v = (unsigned)(x >> (16 * (i & 3))) & 0xffffu;
        u.pm = (int)(v >> 8); u.pn = (int)(v & 255u); return true;
    }
    DI void a_ready(const pg8::Unit&) const {}
    DI void done(const pg8::Unit&) const {}
};

struct InProjOrder {
    pg8::StaticOrder S0; int G, c, offa, offb;
    DI void init(int G_, int c_, int layer) { S0.init(MT, R_G, G_, c_); G = G_; c = c_; offa = -71 + 42 * layer; offb = 108 - 42 * layer; }
    DI bool next(int i, pg8::Unit& u) const {
        if (S0.next(i, u)) return true;
        const int Lv = i * G + c - 66 * 21; if (Lv >= 5 * 66) return false;
        u.pm = Lv % 5 + offa; u.pn = Lv / 5 + offb; return true;
    }
    DI void a_ready(const pg8::Unit&) const {}
    DI void done(const pg8::Unit&) const {}
};
static_assert((WS_WIN + (size_t)R_V * DM * 2) % (256 * 1024 * 2) == (WS_H % (256 * 1024 * 2)) && ((size_t)NINC * DM * 2) % (256 * 1024 * 2) == 0, "tile-offset trick of InProjOrder");

struct MergeOrder {
    pg8::StaticOrder S0;
    DI void init(int M, int G_, int c_) { S0.init(M, DM, G_, c_); }
    DI bool next(int i, pg8::Unit& u) const { if (!S0.next(i >> 2, u)) return false; const int n = i & 3; u.pm += 66 * n; u.pn += 4 * n; return true; }
    DI void a_ready(const pg8::Unit&) const {}
    DI void done(const pg8::Unit&) const {}
};
static_assert(((size_t)MT * 512 * 2) == (size_t)66 * 256 * 512 * 2 && ((size_t)1024 * 512 * 2) == (size_t)4 * 256 * 512 * 2, "tile-offset trick of MergeOrder");

DI int win_dest_row(int n) {
    if (n >= 6656) return R_G + (n - 6656);
    const int mix = (n >= 4608) ? 3 : (n >= 3328) ? 2 : (n >= 1280) ? 1 : 0;
    const int mstart = (mix == 3) ? 4608 : (mix == 2) ? 3328 : (mix == 1) ? 1280 : 0;
    const int o = n - mstart;
    const bool wide = (mix & 1);
    const int kw = wide ? 512 : 128;
    const int qk0 = (mix == 0) ? 0 : (mix == 1) ? 640 : (mix == 2) ? 1664 : 2304;
    const int v0 = (mix == 0) ? 0 : (mix == 1) ? 128 : (mix == 2) ? 640 : 768;
    if (o < 512 + kw) return qk0 + o;
    if (o < 512 + 2 * kw) return R_V + v0 + (o - 512 - kw);
    return R_PG + mix * 512 + (o - 512 - 2 * kw);
}
DI void transpose_item(const float* W, int K, int N, bf16_t* WT, int drow0, LAS float* scr, int k0, int n0, int lane) {
#pragma unroll 8
    for (int i = 0; i < 32; ++i) { const int kk = 2 * i + (lane >> 5); scr[kk * 33 + (lane & 31)] = W[(size_t)(k0 + kk) * N + n0 + (lane & 31)]; }
    asm volatile("s_waitcnt lgkmcnt(0)" ::: "memory");
    const int c = lane & 7;
#pragma unroll
    for (int j = 0; j < 4; ++j) { const int n = (lane >> 3) + 8 * j; const LAS float* s = scr + (8 * c) * 33 + n;
        u32x4 o; o.x = cvtpk(s[0 * 33], s[1 * 33]); o.y = cvtpk(s[2 * 33], s[3 * 33]); o.z = cvtpk(s[4 * 33], s[5 * 33]); o.w = cvtpk(s[6 * 33], s[7 * 33]);
        *(u32x4*)(WT + (size_t)(drow0 + n) * K + k0 + 8 * c) = o; }
    asm volatile("s_waitcnt lgkmcnt(0)" ::: "memory");
}

DI void weight_copies(const Params& P, LAS unsigned char* lds, int l, int gw, int ngw, int wave, int lane) {
    unsigned char* ws = P.ws;
    LAS float* scr = (LAS float*)(lds + 20480 + wave * 8448);
    constexpr int I_IN = 16 * (NINC / 32), I_BR = 8 * 32, I_OUT = 16 * 32, I_L = I_IN + 4 * I_BR + I_OUT;
    for (int it = gw; it < I_L; it += ngw) {
        int rI = it;
        if (rI < I_IN) { const int kb = rI / (NINC / 32), nb = rI % (NINC / 32), n0 = nb * 32;
            transpose_item(P.w_in + (size_t)l * DM * NINC, DM, NINC, (bf16_t*)(ws + WS_WIN) + (size_t)l * NINC * DM, win_dest_row(n0), scr, kb * 64, n0, lane); continue; }
        rI -= I_IN;
        if (rI < 4 * I_BR) { const int n = rI / I_BR, q = rI % I_BR, kb = q / 32, nb = q % 32;
            transpose_item(P.w_br + (size_t)(l * 4 + n) * 512 * 1024, 512, 1024, (bf16_t*)(ws + WS_WBR) + (size_t)(l * 4 + n) * 1024 * 512, nb * 32, scr, kb * 64, nb * 32, lane); continue; }
        rI -= 4 * I_BR;
        { const int kb = rI / 32, nb = rI % 32;
            transpose_item(P.w_out + (size_t)l * DM * DM, DM, DM, (bf16_t*)(ws + WS_WOUT) + (size_t)l * DM * DM, nb * 32, scr, kb * 64, nb * 32, lane); }
    }
}

DI void prologue_phase(const Params& P, LAS unsigned char* lds, int bid, int G, int tid, int lane, int wave) {
    unsigned char* ws = P.ws;
    if (bid < 192) {
        LAS float* sv = (LAS float*)lds;
        LAS float* red = (LAS float*)(lds + 12288);
        for (int i = tid; i < 3072; i += NTHREADS) { const int v = i >> 10, k = i & 1023; const float a = (v < 2) ? P.c[v * 1024 + k] : P.c_ctx[k]; sv[i] = silu_f(a); }
        __syncthreads();
        const int kc = tid >> 5, cl = tid & 31, j = bid * 32 + cl, l = j / 3072, jj = j % 3072;
        const float* wp = P.w_ada + (size_t)l * 1024 * 3072 + jj;
        float a0 = 0.f, a1 = 0.f, a2 = 0.f;
#pragma unroll 8
        for (int k = kc * 64; k < kc * 64 + 64; ++k) { const float w = wp[(size_t)k * 3072]; a0 += sv[k] * w; a1 += sv[1024 + k] * w; a2 += sv[2048 + k] * w; }
        red[(kc * 32 + cl) * 3 + 0] = a0; red[(kc * 32 + cl) * 3 + 1] = a1; red[(kc * 32 + cl) * 3 + 2] = a2;
        __syncthreads();
        if (tid < 96) { const int c2 = tid & 31, v = tid >> 5; float s = 0.f;
#pragma unroll
            for (int q = 0; q < 16; ++q) s += red[(q * 32 + c2) * 3 + v];
            const int j2 = bid * 32 + c2, l2 = j2 / 3072, jj2 = j2 % 3072;
            ((float*)(ws + WS_MOD))[(l2 * 3 + v) * 3072 + jj2] = s + P.b_ada[l2 * 3072 + jj2]; }
        __syncthreads();
    } else if (bid == 192) {
        for (int e = tid; e < 2048; e += NTHREADS) { const int pos = e >> 4, i = e & 15;
            const float fr = __builtin_amdgcn_exp2f(-(float)i * (13.287712379549449f / 16.f));
            const float ang = (float)pos * fr; double rev = (double)ang * 0.15915494309189535; rev -= __builtin_rint(rev);
            f32x2_t cs; cs.x = __builtin_amdgcn_cosf((float)rev); cs.y = __builtin_amdgcn_sinf((float)rev);
            ((f32x2_t*)(ws + WS_ROPE))[e] = cs; }
    } else if (bid == 193) {
        if (tid < 2) { const float* lf = P.lam_d + tid * 256; float s1 = 0.f, s2 = 0.f;
            for (int d = 0; d < 64; ++d) { s1 += lf[d] * lf[64 + d]; s2 += lf[128 + d] * lf[192 + d]; }
            const float lam_init = (tid == 0) ? 0.2f : 0.35550906759f;
            ((float*)(ws + WS_LAM))[tid] = fexp2(s1 * LOG2E) - fexp2(s2 * LOG2E) + lam_init; }
        if (tid >= 64 && tid < 72) { const int l = (tid - 64) >> 2, mx = (tid - 64) & 3; const float* gq = P.qk_gain + l * 512 + mx * 128; float a = 0.f, c = 0.f;
            for (int d = 0; d < 64; ++d) { a = fmaxf(a, fabsf(gq[d])); c = fmaxf(c, fabsf(gq[64 + d])); }
            ((float*)(ws + WS_LAM))[4 + l * 4 + mx] = 64.0f * a * c * QSCALE * 1.02f; }
    }
    weight_copies(P, lds, 0, bid * NWAVES + wave, G * NWAVES, wave, lane);
}

DI void norm_phase(const float* xsrc, const float* csrc, const float* nw, const float* modl, bf16_t* H, int gw, int NGW, int lane) {
    for (int row = gw; row < MT; row += NGW) {
        const float* src; const float* mv;
        if (row < MX) { src = xsrc + (size_t)row * DM; mv = modl + (row >> 13) * 3072; } else { src = csrc + (size_t)(row - MX) * DM; mv = modl + 2 * 3072; }
        f32x4 v[4]; float ss = 0.f;
#pragma unroll
        for (int j = 0; j < 4; ++j) { v[j] = ((const f32x4*)src)[lane + 64 * j]; ss += (v[j].x * v[j].x + v[j].y * v[j].y) + (v[j].z * v[j].z + v[j].w * v[j].w); }
        const float rn = 1.0f / sqrtf(wave_sum(ss) * (1.f / DM) + EPSN);
#pragma unroll
        for (int j = 0; j < 4; ++j) { const int col = 4 * lane + 256 * j;
            const f32x4 w = *(const f32x4*)(nw + col), sh = *(const f32x4*)(mv + col), sc = *(const f32x4*)(mv + 1024 + col);
            const f32x4 y = (v[j] * rn) * w * (sc + 1.0f) + sh;
            u32x2 o; o.x = cvtpk(y.x, y.y); o.y = cvtpk(y.z, y.w);
            *(u32x2*)(H + (size_t)row * DM + col) = o; }
    }
}

DI void prep_item(bf16_t* p, u32x2 raw, int row, int hh, int l16, const float* gain_l, const f32x2_t* rope, bool dry) {
    int mixer, isk;
    if (hh < 8) { mixer = 0; isk = 0; } else if (hh < 10) { mixer = 0; isk = 1; } else if (hh < 18) { mixer = 1; isk = 0; } else if (hh < 26) { mixer = 1; isk = 1; }
    else if (hh < 34) { mixer = 2; isk = 0; } else if (hh < 36) { mixer = 2; isk = 1; } else if (hh < 44) { mixer = 3; isk = 0; } else { mixer = 3; isk = 1; }
    float y0 = bflo(raw.x), y1 = bfhi(raw.x), y2 = bflo(raw.y), y3 = bfhi(raw.y);
    float ss = (y0 * y0 + y1 * y1) + (y2 * y2 + y3 * y3);
    ss += __shfl_xor(ss, 1); ss += __shfl_xor(ss, 2); ss += __shfl_xor(ss, 4); ss += __shfl_xor(ss, 8);
    const float rn = 1.0f / sqrtf(ss * (1.f / 64.f) + EPSN);
    const f32x4 g = *(const f32x4*)(gain_l + (mixer * 2 + isk) * 64 + l16 * 4);
    y0 = y0 * rn * g.x; y1 = y1 * rn * g.y; y2 = y2 * rn * g.z; y3 = y3 * rn * g.w;
    const float p0 = __shfl_xor(y0, 4), p1 = __shfl_xor(y1, 4), p2 = __shfl_xor(y2, 4), p3 = __shfl_xor(y3, 4);
    if (mixer != 1 && row < MX) {
        const int t = row & (SEQ - 1), pos = (l16 < 8) ? (t >> 6) : (t & 63);
        const f32x2_t* rp = rope + pos * 16 + (l16 & 3) * 4;
        const f32x2_t c0 = rp[0], c1 = rp[1], c2 = rp[2], c3 = rp[3];
        const float sg = (l16 & 4) ? 1.f : -1.f;
        y0 = y0 * c0.x + sg * p0 * c0.y; y1 = y1 * c1.x + sg * p1 * c1.y; y2 = y2 * c2.x + sg * p2 * c2.y; y3 = y3 * c3.x + sg * p3 * c3.y;
    }
    if (!isk) { y0 *= QSCALE; y1 *= QSCALE; y2 *= QSCALE; y3 *= QSCALE; }
    u32x2 o; o.x = cvtpk(y0, y1); o.y = cvtpk(y2, y3);
    if (!dry) *(u32x2*)p = o;
}
DI void prep_phase(bf16_t* Pqk, const float* gain_l, const f32x2_t* rope, int gw, int NGW, int lane, bool dry) {
    const int sub = lane >> 4, l16 = lane & 15;
    constexpr int NIT = MT * 20 / 4;
    for (int it0 = gw * 4; it0 < NIT; it0 += NGW * 4) {
        bf16_t* p[4]; u32x2 raw[4]; int row[4], hh[4];
#pragma unroll
        for (int u = 0; u < 4; ++u) { const int it = min(it0 + u, NIT - 1); const int item = it * 4 + sub; row[u] = item / 20; const int kq = item % 20;
            hh[u] = (kq < 2) ? 8 + kq : (kq < 10) ? 16 + kq : (kq < 12) ? 24 + kq : 32 + kq;
            p[u] = Pqk + (size_t)row[u] * NQK + hh[u] * 64 + l16 * 4; raw[u] = *(const u32x2*)p[u]; }
#pragma unroll
        for (int u = 0; u < 4; ++u) if (it0 + u < NIT) prep_item(p[u], raw[u], row[u], hh[u], l16, gain_l, rope, dry);
    }
}

constexpr int KROW = 144, VROW = 144, KBUF = 64 * KROW, VBUF = 128 * VROW, BIAS_OFF = 4 * KBUF + 2 * VBUF, QOFF = BIAS_OFF + 2048;
static_assert(QOFF + 8 * 4096 <= 131072 && BIAS_OFF + 2048 <= LDS_BYTES && 4 * 64 * 64 * 4 <= BIAS_OFF, "attention LDS map");
#define MFMA32(a, b, c) __builtin_amdgcn_mfma_f32_32x32x16_bf16((a), (b), (c), 0, 0, 0)

DI float swapmax(float m) { auto rr = __builtin_amdgcn_permlane32_swap(__float_as_uint(m), __float_as_uint(m), false, false); return fmaxf(__uint_as_float(rr[0]), __uint_as_float(rr[1])); }
DI float swapsum(float m) { auto rr = __builtin_amdgcn_permlane32_swap(__float_as_uint(m), __float_as_uint(m), false, false); return __uint_as_float(rr[0]) + __uint_as_float(rr[1]); }
#define KOFF(bf) ((bf) * 2 * KBUF)
#define VOFF(bf) (4 * KBUF + (bf) * VBUF)
template <int TYPE, bool FASTP>
DI void attn_unit(LAS unsigned char* lds, const bf16_t* __restrict__ Pqk, const bf16_t* __restrict__ Vt, bf16_t* Ymix,
                  int b, int h, int qb, bool isctx, float sink_l2, const float* rpb_h, const float* lamp, int layer_i, const float* subln, bool dry, float mref_fixed, int tid_in, const float* gain_q, const f32x2_t* rope) {
    constexpr int DV = (TYPE == 3) ? 128 : 64, NDB = DV / 32;
    int tid_op = tid_in; asm volatile("" : "+v"(tid_op));
    const int tid = tid_op, lane = tid & 63, r = lane & 31, hi = lane >> 5;
    const int w = __builtin_amdgcn_readfirstlane(tid >> 6);
    const int kset = (TYPE == 3) ? (w >> 2) : 0, wq = (TYPE == 3) ? (w & 3) : w;
    const int qtok = ((TYPE == 3) ? 128 : 256) * qb + 32 * wq;
    const int ctxrow = MX + b * CTXL, latrow = b * SEQ;
    const int qrow0 = isctx ? (ctxrow + qtok) : (latrow + qtok);
    int qcol, kcol, vrow;
    if (TYPE == 0) { qcol = h * 64; kcol = 512 + (h >> 2) * 64; vrow = (h >> 2) * 64; }
    else if (TYPE == 1) { qcol = 640 + h * 64; kcol = 1152 + h * 64; vrow = 128 + h * 64; }
    else if (TYPE == 2) { qcol = 1664 + h * 64; kcol = 2176 + (h >> 2) * 64; vrow = 640 + (h >> 2) * 64; }
    else { qcol = 2304 + (2 * h + kset) * 64; kcol = 2816 + 2 * h * 64; vrow = 768 + h * 128; }
    int tl0 = 0, tl1 = 0;
    if (!isctx) {
        if (TYPE == 0) { tl0 = max(0, 4 * qb - 2); tl1 = min(128, 4 * qb + 6); }
        else if (TYPE == 1) { tl0 = min(max(4 * qb - 4, 0), 120); tl1 = min(max(4 * qb + 3 - 4, 0), 120) + 8; }
        else { tl0 = 0; tl1 = 128; }
    }
    const int NT = 4 + (tl1 - tl0);
    if (TYPE == 1 && !isctx) { if (tid < 465) ((LAS float*)(lds + BIAS_OFF))[tid] = rpb_h[tid] * LOG2E; }
    bf16x8 qr[4];
    { const bf16_t* qp = Pqk + (size_t)(qrow0 + r) * NQK + qcol + hi * 8;
#pragma unroll
        for (int d0 = 0; d0 < 4; ++d0) qr[d0] = *(const bf16x8*)(qp + d0 * 16); }
    { float x[4][8]; float ss = 0.f;
#pragma unroll
        for (int d0 = 0; d0 < 4; ++d0)
#pragma unroll
            for (int e = 0; e < 8; ++e) { x[d0][e] = __uint_as_float(((unsigned)(unsigned short)qr[d0][e]) << 16); ss += x[d0][e] * x[d0][e]; }
        ss = swapsum(ss);
        const float rn = (1.0f / sqrtf(ss * (1.f / 64.f) + EPSN));
#pragma unroll
        for (int d0 = 0; d0 < 4; ++d0) { const f32x4 g0 = *(const f32x4*)(gain_q + d0 * 16 + hi * 8), g1 = *(const f32x4*)(gain_q + d0 * 16 + hi * 8 + 4);
            x[d0][0] *= rn * g0.x; x[d0][1] *= rn * g0.y; x[d0][2] *= rn * g0.z; x[d0][3] *= rn * g0.w; x[d0][4] *= rn * g1.x; x[d0][5] *= rn * g1.y; x[d0][6] *= rn * g1.z; x[d0][7] *= rn * g1.w; }
        if (TYPE != 1 && !isctx) { const int t = qtok + r;
#pragma unroll
            for (int a = 0; a < 2; ++a) { const int pos = a ? (t & 63) : (t >> 6); const f32x2_t* rp = rope + pos * 16 + hi * 8;
#pragma unroll
                for (int e = 0; e < 8; ++e) { const f32x2_t cs = rp[e]; const float y0 = x[2 * a][e], y1 = x[2 * a + 1][e]; x[2 * a][e] = y0 * cs.x - y1 * cs.y; x[2 * a + 1][e] = y1 * cs.x + y0 * cs.y; } } }
#pragma unroll
        for (int d0 = 0; d0 < 4; ++d0) { u32x4 t4; t4.x = cvtpk(x[d0][0] * QSCALE, x[d0][1] * QSCALE); t4.y = cvtpk(x[d0][2] * QSCALE, x[d0][3] * QSCALE); t4.z = cvtpk(x[d0][4] * QSCALE, x[d0][5] * QSCALE); t4.w = cvtpk(x[d0][6] * QSCALE, x[d0][7] * QSCALE);
            qr[d0] = __builtin_bit_cast(bf16x8, t4); } }
    constexpr bool QLDS = (TYPE == 3 && !FASTP);
    LAS unsigned char* qlds = lds + QOFF + w * 4096 + r * 128 + hi * 16;
    if (QLDS) {
#pragma unroll
        for (int d0 = 0; d0 < 4; ++d0) *(LAS bf16x8*)(qlds + d0 * 32) = qr[d0];
    }
#define QFRAG(d0) (QLDS ? *(LAS const bf16x8*)(qlds + (d0) * 32) : qr[d0])
    f32x16 o[NDB];
#pragma unroll
    for (int db = 0; db < NDB; ++db)
#pragma unroll
        for (int i = 0; i < 16; ++i) o[db][i] = 0.f;
    float mref = 0.f, l = 0.f;
    if (TYPE == 0) { mref = sink_l2; l = (hi == 0) ? 1.f : 0.f; }
    const int lrow = tid >> 3, lch = tid & 7;
    u32x4 kA0, kA1, vA0, vA1, kB0, kB1, vB0, vB1;
#define ATT_TB(j) (((j) < 4) ? ctxrow + 64 * (j) : latrow + 64 * (tl0 + (j) - 4))
#define ATT_LOADK(j, K0, K1) do { const bf16_t* kp_ = Pqk + (size_t)(ATT_TB(j) + lrow) * NQK + kcol + lch * 8; K0 = *(const u32x4*)kp_; if (TYPE == 3) K1 = *(const u32x4*)(kp_ + 64); } while (0)
#define ATT_LOADV(j, V0, V1) do { const bf16_t* vp_ = Vt + (size_t)(vrow + lrow) * MT + ATT_TB(j) + lch * 8; V0 = *(const u32x4*)vp_; if (TYPE == 3) V1 = *(const u32x4*)(vp_ + (size_t)64 * MT); } while (0)
#define ATT_STOREK(bf, K0, K1) do { LAS unsigned char* sb_ = lds + KOFF(bf); *(LAS u32x4*)(sb_ + lrow * KROW + lch * 16) = K0; if (TYPE == 3) *(LAS u32x4*)(sb_ + KBUF + lrow * KROW + lch * 16) = K1; } while (0)
#define ATT_STOREV(bf, V0, V1) do { LAS unsigned char* vb_ = lds + VOFF(bf) + lrow * VROW + (lch >> 1) * 32 + (lch & 1) * 8;     \
        *(LAS u32x2*)vb_ = (u32x2){V0.x, V0.y}; *(LAS u32x2*)(vb_ + 16) = (u32x2){V0.z, V0.w}; \
        if (TYPE == 3) { *(LAS u32x2*)(vb_ + 64 * VROW) = (u32x2){V1.x, V1.y}; *(LAS u32x2*)(vb_ + 64 * VROW + 16) = (u32x2){V1.z, V1.w}; } } while (0)
    const float NEG = -__builtin_inff();
    unsigned okmask = 0u;
    if (TYPE == 1) { const int qc = 32 * (wq & 1) + r, cs = min(max(qc - 8, 0), 48);
#pragma unroll
        for (int i = 0; i < 16; ++i) { const int kc = (i & 3) + 8 * (i >> 2) + 4 * hi; if (kc >= cs && kc < cs + 16) okmask |= 1u << i; if (kc + 32 >= cs && kc + 32 < cs + 16) okmask |= 1u << (16 + i); } }
#define SGB(m, n) __builtin_amdgcn_sched_group_barrier((m), (n), 0)
#define ATT_STEP(SC, SN, DOQK, KBF, KHF, VBF, VHF, MK, PA, FAST, PSUM, KF, KN, NKBF, NKHF, DONEXT) do { \
        LAS const unsigned char* Vb_ = lds + VOFF(VBF) + r * VROW + hi * 16 + (VHF) * 64; \
        bf16x8 va_[NDB][2]; bf16x8 ka_, kb_, kc_, kd_; \
        if (NDB == 2) { _Pragma("unroll") for (int db_ = 0; db_ < NDB; ++db_) { va_[db_][0] = *(LAS const bf16x8*)(Vb_ + db_ * 32 * VROW); va_[db_][1] = *(LAS const bf16x8*)(Vb_ + db_ * 32 * VROW + 32); } } \
        if (KPF) { ka_ = KF[0]; kb_ = KF[1]; kc_ = KF[2]; kd_ = KF[3]; \
            if (DONEXT) { LAS const unsigned char* Kn_ = lds + KOFF(NKBF) + kset * KBUF + ((NKHF) * 32 + r) * KROW + hi * 16; \
                KN[0] = *(LAS const bf16x8*)(Kn_); KN[1] = *(LAS const bf16x8*)(Kn_ + 32); KN[2] = *(LAS const bf16x8*)(Kn_ + 64); KN[3] = *(LAS const bf16x8*)(Kn_ + 96); } } \
        else if (DOQK) { LAS const unsigned char* Kb_ = lds + KOFF(KBF) + kset * KBUF + ((KHF) * 32 + r) * KROW + hi * 16; \
            ka_ = *(LAS const bf16x8*)(Kb_); kb_ = *(LAS const bf16x8*)(Kb_ + 32); kc_ = *(LAS const bf16x8*)(Kb_ + 64); kd_ = *(LAS const bf16x8*)(Kb_ + 96); } \
        if (TYPE == 0 && (MK) == 1) { _Pragma("unroll") for (int i_ = 0; i_ < 16; ++i_) { const int d_ = (PA) + 32 * (VHF) + (i_ & 3) + 8 * (i_ >> 2); if (d_ > 128 || d_ < -128) SC[i_] = NEG; } } \
        if (TYPE == 1 && (MK) == 2) { unsigned okm_ = okmask; int dcb_ = 4 * hi - (32 * (wq & 1) + r) + 15 + (PA) + 32 * (VHF); asm volatile("" : "+v"(okm_), "+v"(dcb_)); \
            LAS const float* bl_ = (LAS const float*)(lds + BIAS_OFF) + dcb_; \
            _Pragma("unroll") for (int i_ = 0; i_ < 16; ++i_) { const float bv_ = bl_[(i_ & 3) + 8 * (i_ >> 2)]; SC[i_] = ((okm_ >> (16 * (VHF) + i_)) & 1u) ? SC[i_] + bv_ : NEG; } } \
        f32x16 z_; _Pragma("unroll") for (int i_ = 0; i_ < 16; ++i_) z_[i_] = 0.f; \
        if (DOQK) SN = MFMA32(ka_, QFRAG(0), z_); \
        _Pragma("unroll") for (int i_ = 0; i_ < 8; ++i_) SC[i_] = (FAST) ? fexp2(SC[i_]) : fexp2(SC[i_] - mref); \
        if (DOQK) SN = MFMA32(kb_, QFRAG(1), SN); \
        u32x4 t0_, t1_; t0_.x = cvtpk(SC[0], SC[1]); t0_.y = cvtpk(SC[2], SC[3]); t0_.z = cvtpk(SC[4], SC[5]); t0_.w = cvtpk(SC[6], SC[7]); \
        if (DOQK) SN = MFMA32(kc_, QFRAG(2), SN); \
        _Pragma("unroll") for (int i_ = 8; i_ < 16; ++i_) SC[i_] = (FAST) ? fexp2(SC[i_]) : fexp2(SC[i_] - mref); \
        if (DOQK) SN = MFMA32(kd_, QFRAG(3), SN); \
        t1_.x = cvtpk(SC[8], SC[9]); t1_.y = cvtpk(SC[10], SC[11]); t1_.z = cvtpk(SC[12], SC[13]); t1_.w = cvtpk(SC[14], SC[15]); \
        const bf16x8 pf0_ = __builtin_bit_cast(bf16x8, t0_), pf1_ = __builtin_bit_cast(bf16x8, t1_); \
        float ps_ = PSUM; \
        _Pragma("unroll") for (int db_ = 0; db_ < NDB; ++db_) { \
            if (NDB != 2) { va_[db_][0] = *(LAS const bf16x8*)(Vb_ + db_ * 32 * VROW); va_[db_][1] = *(LAS const bf16x8*)(Vb_ + db_ * 32 * VROW + 32); } \
            o[db_] = MFMA32(va_[db_][0], pf0_, o[db_]); \
            _Pragma("unroll") for (int i_ = 0; i_ < 8 / NDB; ++i_) ps_ += SC[db_ * (8 / NDB) + i_]; \
            o[db_] = MFMA32(va_[db_][1], pf1_, o[db_]); \
            _Pragma("unroll") for (int i_ = 0; i_ < 8 / NDB; ++i_) ps_ += SC[8 + db_ * (8 / NDB) + i_]; } \
        PSUM = ps_; \
        if (TYPE == 2) { SGB(0x100, ((KPF ? (DONEXT) : (DOQK)) ? 4 : 0) + 2 * NDB); \
            if (DOQK) { SGB(0x008, 1); SGB(0x402, (FAST) ? 8 : 16); SGB(0x008, 1); SGB(0x402, 4); SGB(0x008, 1); SGB(0x402, (FAST) ? 8 : 16); SGB(0x008, 1); SGB(0x402, 4); } \
            _Pragma("unroll") for (int db_ = 0; db_ < 2 * NDB; ++db_) { SGB(0x008, 1); SGB(0x402, 8 / NDB); } } } while (0)
#define ATT_RESCALE(PSUM) do { const float c0_ = swapmax(PSUM); \
        if (__any(c0_ > 8192.0f)) { const float c_ = fmaxf(c0_ * (1.0f / 32.0f), 1.0f), sc_ = __builtin_amdgcn_rcpf(c_); mref += __builtin_amdgcn_logf(c_); l *= sc_; \
            _Pragma("unroll") for (int db_ = 0; db_ < NDB; ++db_) o[db_] = o[db_] * sc_; } } while (0)
#define ATT_TILEINFO(j, skip, mk, pa) do { skip = false; mk = 0; pa = 0; if ((j) >= 4) { \
        if (TYPE == 0) { const int kp0_ = 64 * (tl0 + (j) - 4); skip = (kp0_ + 63 < qtok - 128) || (kp0_ > qtok + 31 + 128); mk = 1; pa = kp0_ - (qtok + r) + 4 * hi; } \
        if (TYPE == 1) { const int kr_ = tl0 + (j) - 4, qrw_ = 4 * qb + (wq >> 1), rs_ = min(max(qrw_ - 4, 0), 120); skip = (kr_ < rs_) || (kr_ >= rs_ + 8); mk = 2; pa = (kr_ - qrw_ + 7) * 31; } } } while (0)
    ATT_LOADK(0, kA0, kA1); ATT_STOREK(0, kA0, kA1); ATT_LOADV(0, vA0, vA1); ATT_STOREV(0, vA0, vA1); ATT_LOADK(1, kA0, kA1); ATT_STOREK(1, kA0, kA1);
    constexpr bool DEEP = false;
    if (DEEP) { ATT_LOADK(2, kB0, kB1); ATT_LOADV(1, vB0, vB1); }
    __syncthreads();
    f32x16 sc, sn;
    constexpr bool KPF = (TYPE >= 2);
    bf16x8 kfA[4], kfB[4];
    if (KPF) { LAS const unsigned char* Kn_ = lds + KOFF(0) + kset * KBUF + (32 + r) * KROW + hi * 16;
        kfA[0] = *(LAS const bf16x8*)(Kn_); kfA[1] = *(LAS const bf16x8*)(Kn_ + 32); kfA[2] = *(LAS const bf16x8*)(Kn_ + 64); kfA[3] = *(LAS const bf16x8*)(Kn_ + 96); }
    { LAS const unsigned char* Kb_ = lds + KOFF(0) + kset * KBUF + r * KROW + hi * 16;
        const bf16x8 ka_ = *(LAS const bf16x8*)(Kb_), kb_ = *(LAS const bf16x8*)(Kb_ + 32), kc_ = *(LAS const bf16x8*)(Kb_ + 64), kd_ = *(LAS const bf16x8*)(Kb_ + 96);
        f32x16 z_;
#pragma unroll
        for (int i_ = 0; i_ < 16; ++i_) z_[i_] = 0.f;
        sc = MFMA32(ka_, QFRAG(0), z_); sc = MFMA32(kb_, QFRAG(1), sc); sc = MFMA32(kc_, QFRAG(2), sc); sc = MFMA32(kd_, QFRAG(3), sc); }
#define ATT_ITER(j, LK0, LK1, LV0, LV1, SK0, SK1, SV0, SV1, FST, NXT) do { \
        if (TYPE != 3) { if ((j) + 2 < NT) ATT_LOADK((j) + 2, SK0, SK1); if ((j) + 1 < NT) ATT_LOADV((j) + 1, SV0, SV1); } \
        float psum = 0.f; \
        if (TYPE >= 2) { \
            ATT_STEP(sc, sn, true, (j) & 1, 1, (j) & 1, 0, 0, 0, FST, psum, kfA, kfB, ((j) + 1) & 1, 0, NXT); \
            if (TYPE == 3) { if ((j) + 2 < NT) ATT_LOADK((j) + 2, SK0, SK1); if ((j) + 1 < NT) ATT_LOADV((j) + 1, SV0, SV1); } \
            if (NXT) ATT_STEP(sn, sc, true, ((j) + 1) & 1, 0, (j) & 1, 1, 0, 0, FST, psum, kfB, kfA, ((j) + 1) & 1, 1, true); else ATT_STEP(sn, sc, false, 0, 0, (j) & 1, 1, 0, 0, FST, psum, kfB, kfA, 0, 0, false); \
        } else { \
            bool skipj, skipn = true; int mk, pa, mkn = 0, pan = 0; \
            ATT_TILEINFO(j, skipj, mk, pa); \
            if ((j) + 1 < NT) ATT_TILEINFO((j) + 1, skipn, mkn, pan); \
            if (!skipj) { ATT_STEP(sc, sn, true, (j) & 1, 1, (j) & 1, 0, mk, pa, false, psum, kfA, kfB, 0, 0, false); \
                if (!skipn) ATT_STEP(sn, sc, true, ((j) + 1) & 1, 0, (j) & 1, 1, mk, pa, false, psum, kfA, kfB, 0, 0, false); else ATT_STEP(sn, sc, false, 0, 0, (j) & 1, 1, mk, pa, false, psum, kfA, kfB, 0, 0, false); } \
            else if (!skipn) { LAS const unsigned char* Kb_ = lds + KOFF(((j) + 1) & 1) + kset * KBUF + r * KROW + hi * 16; \
                const bf16x8 ka_ = *(LAS const bf16x8*)(Kb_), kb_ = *(LAS const bf16x8*)(Kb_ + 32), kc_ = *(LAS const bf16x8*)(Kb_ + 64), kd_ = *(LAS const bf16x8*)(Kb_ + 96); \
                f32x16 z_; _Pragma("unroll") for (int i_ = 0; i_ < 16; ++i_) z_[i_] = 0.f; \
                sc = MFMA32(ka_, QFRAG(0), z_); sc = MFMA32(kb_, QFRAG(1), sc); sc = MFMA32(kc_, QFRAG(2), sc); sc = MFMA32(kd_, QFRAG(3), sc); } \
        } \
        l += psum; \
        if (TYPE < 2 || !(FST)) ATT_RESCALE(psum); \
        if ((j) + 2 < NT) ATT_STOREK((j) & 1, SK0, SK1); \
        if ((j) + 1 < NT) ATT_STOREV(((j) + 1) & 1, SV0, SV1); \
        __syncthreads(); } while (0)
    if (TYPE >= 2) { for (int j = 0; j < NT - 1; ++j) ATT_ITER(j, kA0, kA1, vA0, vA1, kA0, kA1, vA0, vA1, FASTP, true);
        { const int j = NT - 1; ATT_ITER(j, kA0, kA1, vA0, vA1, kA0, kA1, vA0, vA1, FASTP, false); } }
    else { for (int j = 0; j < NT; ++j) ATT_ITER(j, kA0, kA1, vA0, vA1, kA0, kA1, vA0, vA1, false, false); }
#undef ATT_ITER
#undef QFRAG
#undef ATT_STEP
#undef ATT_RESCALE
#undef SGB
#undef ATT_TB
#undef ATT_LOADK
#undef ATT_LOADV
#undef ATT_STOREK
#undef ATT_STOREV
#undef ATT_TILEINFO
    const float lt = swapsum(l), inv = 1.0f / lt;
    if (TYPE != 3) {
        bf16_t* yrow = Ymix + (size_t)(qrow0 + r) * 512 + h * 64 + 4 * hi;
#pragma unroll
        for (int db = 0; db < NDB; ++db)
#pragma unroll
            for (int g = 0; g < 4; ++g) { bf16_t* yp = yrow + 32 * db + 8 * g; const u32x2 gt = *(const u32x2*)yp;
                u32x2 ov; ov.x = cvtpk(o[db][4 * g] * inv * bflo(gt.x), o[db][4 * g + 1] * inv * bfhi(gt.x)); ov.y = cvtpk(o[db][4 * g + 2] * inv * bflo(gt.y), o[db][4 * g + 3] * inv * bfhi(gt.y));
                if (!dry) *(u32x2*)yp = ov; }
    } else {
        LAS float* ex = (LAS float*)lds + (size_t)wq * 64 * 64 + lane;
        if (kset == 1) {
#pragma unroll
            for (int db = 0; db < NDB; ++db)
#pragma unroll
                for (int i = 0; i < 16; ++i) ex[(db * 16 + i) * 64] = o[db][i] * inv;
        }
        __syncthreads();
        if (kset == 0) {
            const float lam = lamp[0], lam_init = (layer_i == 0) ? 0.2f : 0.35550906759f;
            float ss = 0.f;
#pragma unroll
            for (int db = 0; db < NDB; ++db)
#pragma unroll
                for (int i = 0; i < 16; ++i) { const float v = o[db][i] * inv - lam * ex[(db * 16 + i) * 64]; o[db][i] = v; ss += v * v; }
            ss = swapsum(ss);
            const float rs = (1.0f / sqrtf(ss * (1.f / 128.f) + EPSN)) * (1.f - lam_init);
            bf16_t* yrow = Ymix + (size_t)(qrow0 + r) * 512 + h * 128 + 4 * hi;
#pragma unroll
            for (int db = 0; db < NDB; ++db)
#pragma unroll
                for (int g = 0; g < 4; ++g) { const int d = 32 * db + 8 * g; bf16_t* yp = yrow + d; const u32x2 gt = *(const u32x2*)yp; const f32x4 sl = *(const f32x4*)(subln + d + 4 * hi);
                    u32x2 ov; ov.x = cvtpk(o[db][4 * g] * rs * sl.x * bflo(gt.x), o[db][4 * g + 1] * rs * sl.y * bfhi(gt.x));
                    ov.y = cvtpk(o[db][4 * g + 2] * rs * sl.z * bflo(gt.y), o[db][4 * g + 3] * rs * sl.w * bfhi(gt.y));
                    if (!dry) *(u32x2*)yp = ov; }
        }
        __syncthreads();
    }
}

DI void attn_unit_c2(LAS unsigned char* lds, const bf16_t* __restrict__ Pqk, const bf16_t* __restrict__ Vt, bf16_t* Ymix, int b, int hp, int qb, bool isctx, bool dry, int tid_in,
                     const float* gain_q, const f32x2_t* rope) {
    int tid_op = tid_in; asm volatile("" : "+v"(tid_op));
    const int tid = tid_op, lane = tid & 63, r = lane & 31, hi = lane >> 5;
    const int w = __builtin_amdgcn_readfirstlane(tid >> 6);
    const int qtok = 256 * qb + 32 * w;
    const int ctxrow = MX + b * CTXL, latrow = b * SEQ;
    const int qrow0 = isctx ? (ctxrow + qtok) : (latrow + qtok);
    const int kcol = 2176 + (hp >> 1) * 64, vrow = 640 + (hp >> 1) * 64;
    const int NT = isctx ? 4 : 132;
    bf16x8 qr[2][4];
#pragma unroll
    for (int hh = 0; hh < 2; ++hh) {
        const bf16_t* qp = Pqk + (size_t)(qrow0 + r) * NQK + 1664 + (2 * hp + hh) * 64 + hi * 8;
#pragma unroll
        for (int d0 = 0; d0 < 4; ++d0) qr[hh][d0] = *(const bf16x8*)(qp + d0 * 16);
        float x[4][8]; float ss = 0.f;
#pragma unroll
        for (int d0 = 0; d0 < 4; ++d0)
#pragma unroll
            for (int e = 0; e < 8; ++e) { x[d0][e] = __uint_as_float(((unsigned)(unsigned short)qr[hh][d0][e]) << 16); ss += x[d0][e] * x[d0][e]; }
        ss = swapsum(ss);
        const float rn = (1.0f / sqrtf(ss * (1.f / 64.f) + EPSN));
#pragma unroll
        for (int d0 = 0; d0 < 4; ++d0) { const f32x4 g0 = *(const f32x4*)(gain_q + d0 * 16 + hi * 8), g1 = *(const f32x4*)(gain_q + d0 * 16 + hi * 8 + 4);
            x[d0][0] *= rn * g0.x; x[d0][1] *= rn * g0.y; x[d0][2] *= rn * g0.z; x[d0][3] *= rn * g0.w; x[d0][4] *= rn * g1.x; x[d0][5] *= rn * g1.y; x[d0][6] *= rn * g1.z; x[d0][7] *= rn * g1.w; }
        if (!isctx) { const int t = qtok + r;
#pragma unroll
            for (int a = 0; a < 2; ++a) { const int pos = a ? (t & 63) : (t >> 6); const f32x2_t* rp = rope + pos * 16 + hi * 8;
#pragma unroll
                for (int e = 0; e < 8; ++e) { const f32x2_t cs = rp[e]; const float y0 = x[2 * a][e], y1 = x[2 * a + 1][e]; x[2 * a][e] = y0 * cs.x - y1 * cs.y; x[2 * a + 1][e] = y1 * cs.x + y0 * cs.y; } } }
#pragma unroll
        for (int d0 = 0; d0 < 4; ++d0) { u32x4 t4; t4.x = cvtpk(x[d0][0] * QSCALE, x[d0][1] * QSCALE); t4.y = cvtpk(x[d0][2] * QSCALE, x[d0][3] * QSCALE); t4.z = cvtpk(x[d0][4] * QSCALE, x[d0][5] * QSCALE); t4.w = cvtpk(x[d0][6] * QSCALE, x[d0][7] * QSCALE);
            qr[hh][d0] = __builtin_bit_cast(bf16x8, t4); }
    }
    f32x16 o[2][2];
#pragma unroll
    for (int hh = 0; hh < 2; ++hh)
#pragma unroll
        for (int db = 0; db < 2; ++db)
#pragma unroll
            for (int i = 0; i < 16; ++i) o[hh][db][i] = 0.f;
    float l0 = 0.f, l1 = 0.f;
    const int lrow = tid >> 3, lch = tid & 7;
    u32x4 kA, vA;
#define C2_TB(j) (((j) < 4) ? ctxrow + 64 * (j) : latrow + 64 * ((j) - 4))
#define C2_LOADK(j) do { kA = *(const u32x4*)(Pqk + (size_t)(C2_TB(j) + lrow) * NQK + kcol + lch * 8); } while (0)
#define C2_LOADV(j) do { vA = *(const u32x4*)(Vt + (size_t)(vrow + lrow) * MT + C2_TB(j) + lch * 8); } while (0)
#define C2_STOREK(bf) do { *(LAS u32x4*)(lds + KOFF(bf) + lrow * KROW + lch * 16) = kA; } while (0)
#define C2_STOREV(bf) do { LAS unsigned char* vb_ = lds + VOFF(bf) + lrow * VROW + (lch >> 1) * 32 + (lch & 1) * 8; *(LAS u32x2*)vb_ = (u32x2){vA.x, vA.y}; *(LAS u32x2*)(vb_ + 16) = (u32x2){vA.z, vA.w}; } while (0)
#define C2_KFRAGS(bf, hf) do { LAS const unsigned char* Kn_ = lds + KOFF(bf) + ((hf) * 32 + r) * KROW + hi * 16; \
        kf[0] = *(LAS const bf16x8*)(Kn_); kf[1] = *(LAS const bf16x8*)(Kn_ + 32); kf[2] = *(LAS const bf16x8*)(Kn_ + 64); kf[3] = *(LAS const bf16x8*)(Kn_ + 96); } while (0)
#define C2_STEP(DONEXT, NKBF, NKHF, VBF, VHF) do { \
        LAS const unsigned char* Vb_ = lds + VOFF(VBF) + r * VROW + hi * 16 + (VHF) * 64; \
        const bf16x8 va00_ = *(LAS const bf16x8*)(Vb_), va01_ = *(LAS const bf16x8*)(Vb_ + 32), va10_ = *(LAS const bf16x8*)(Vb_ + 32 * VROW), va11_ = *(LAS const bf16x8*)(Vb_ + 32 * VROW + 32); \
        f32x16 s0_, s1_; { f32x16 z_; _Pragma("unroll") for (int i_ = 0; i_ < 16; ++i_) z_[i_] = 0.f; __builtin_amdgcn_s_setprio(1); \
            s0_ = MFMA32(kf[0], qr[0][0], z_); s1_ = MFMA32(kf[0], qr[1][0], z_); s0_ = MFMA32(kf[1], qr[0][1], s0_); s1_ = MFMA32(kf[1], qr[1][1], s1_); \
            s0_ = MFMA32(kf[2], qr[0][2], s0_); s1_ = MFMA32(kf[2], qr[1][2], s1_); s0_ = MFMA32(kf[3], qr[0][3], s0_); s1_ = MFMA32(kf[3], qr[1][3], s1_); __builtin_amdgcn_s_setprio(0); } \
        if (DONEXT) C2_KFRAGS(NKBF, NKHF); \
        _Pragma("unroll") for (int i_ = 0; i_ < 16; ++i_) s0_[i_] = fexp2(s0_[i_]); \
        u32x4 t0_, t1_; \
        t0_.x = cvtpk(s0_[0], s0_[1]); t0_.y = cvtpk(s0_[2], s0_[3]); t0_.z = cvtpk(s0_[4], s0_[5]); t0_.w = cvtpk(s0_[6], s0_[7]); \
        t1_.x = cvtpk(s0_[8], s0_[9]); t1_.y = cvtpk(s0_[10], s0_[11]); t1_.z = cvtpk(s0_[12], s0_[13]); t1_.w = cvtpk(s0_[14], s0_[15]); \
        const bf16x8 p00_ = __builtin_bit_cast(bf16x8, t0_), p01_ = __builtin_bit_cast(bf16x8, t1_); \
        o[0][0] = MFMA32(va00_, p00_, o[0][0]); o[0][1] = MFMA32(va10_, p00_, o[0][1]); o[0][0] = MFMA32(va01_, p01_, o[0][0]); o[0][1] = MFMA32(va11_, p01_, o[0][1]); \
        _Pragma("unroll") for (int i_ = 0; i_ < 16; ++i_) s1_[i_] = fexp2(s1_[i_]); \
        u32x4 t2_, t3_; \
        t2_.x = cvtpk(s1_[0], s1_[1]); t2_.y = cvtpk(s1_[2], s1_[3]); t2_.z = cvtpk(s1_[4], s1_[5]); t2_.w = cvtpk(s1_[6], s1_[7]); \
        t3_.x = cvtpk(s1_[8], s1_[9]); t3_.y = cvtpk(s1_[10], s1_[11]); t3_.z = cvtpk(s1_[12], s1_[13]); t3_.w = cvtpk(s1_[14], s1_[15]); \
        const bf16x8 p10_ = __builtin_bit_cast(bf16x8, t2_), p11_ = __builtin_bit_cast(bf16x8, t3_); \
        o[1][0] = MFMA32(va00_, p10_, o[1][0]); o[1][1] = MFMA32(va10_, p10_, o[1][1]); o[1][0] = MFMA32(va01_, p11_, o[1][0]); o[1][1] = MFMA32(va11_, p11_, o[1][1]); \
        float a0_ = 0.f, a1_ = 0.f; _Pragma("unroll") for (int i_ = 0; i_ < 16; ++i_) { a0_ += s0_[i_]; a1_ += s1_[i_]; } \
        l0 += a0_; l1 += a1_; } while (0)
    C2_LOADK(0); C2_STOREK(0); C2_LOADV(0); C2_STOREV(0); C2_LOADK(1); C2_STOREK(1);
    __syncthreads();
    bf16x8 kf[4];
    C2_KFRAGS(0, 0);
    for (int j = 0; j < NT - 1; ++j) {
        if (j + 2 < NT) C2_LOADK(j + 2);
        C2_LOADV(j + 1);
        C2_STEP(true, j & 1, 1, j & 1, 0);
        C2_STEP(true, (j + 1) & 1, 0, j & 1, 1);
        if (j + 2 < NT) C2_STOREK(j & 1);
        C2_STOREV((j + 1) & 1);
        __syncthreads();
    }
    { const int j = NT - 1;
        C2_STEP(true, j & 1, 1, j & 1, 0);
        C2_STEP(false, 0, 0, j & 1, 1);
        __syncthreads(); }
#undef C2_TB
#undef C2_LOADK
#undef C2_LOADV
#undef C2_STOREK
#undef C2_STOREV
#undef C2_KFRAGS
#undef C2_STEP
#pragma unroll
    for (int hh = 0; hh < 2; ++hh) {
        const float inv = 1.0f / swapsum(hh ? l1 : l0);
        bf16_t* yrow = Ymix + (size_t)(qrow0 + r) * 512 + (2 * hp + hh) * 64 + 4 * hi;
#pragma unroll
        for (int db = 0; db < 2; ++db)
#pragma unroll
            for (int g = 0; g < 4; ++g) { bf16_t* yp = yrow + 32 * db + 8 * g; const u32x2 gt = *(const u32x2*)yp;
                u32x2 ov; ov.x = cvtpk(o[hh][db][4 * g] * inv * bflo(gt.x), o[hh][db][4 * g + 1] * inv * bfhi(gt.x)); ov.y = cvtpk(o[hh][db][4 * g + 2] * inv * bflo(gt.y), o[hh][db][4 * g + 3] * inv * bfhi(gt.y));
                if (!dry) *(u32x2*)yp = ov; }
    }
}

DI void attn_unit_d2(LAS unsigned char* lds, const bf16_t* __restrict__ Pqk, const bf16_t* __restrict__ Vt, bf16_t* Ymix, int b, int h, int qb, bool isctx, int tid_in,
                     const float* gain_q, const f32x2_t* rope, const float* lamp, int layer_i, const float* subln) {
    int tid_op = tid_in; asm volatile("" : "+v"(tid_op));
    const int tid = tid_op, lane = tid & 63, r = lane & 31, hi = lane >> 5;
    const int w = __builtin_amdgcn_readfirstlane(tid >> 6);
    const int kset = w >> 2, wq = w & 3;
    const int qtok = 128 * qb + 32 * wq;
    const int ctxrow = MX + b * CTXL, latrow = b * SEQ;
    const int qrow0 = isctx ? (ctxrow + qtok) : (latrow + qtok);
    const int kcol = 2816 + 2 * h * 64, vrow = 768 + h * 128;
    const int NT = isctx ? 4 : 132;
    bf16x8 qr[4];
    { const bf16_t* qp = Pqk + (size_t)(qrow0 + r) * NQK + 2304 + (2 * h + kset) * 64 + hi * 8;
#pragma unroll
        for (int d0 = 0; d0 < 4; ++d0) qr[d0] = *(const bf16x8*)(qp + d0 * 16);
        float x[4][8]; float ss = 0.f;
#pragma unroll
        for (int d0 = 0; d0 < 4; ++d0)
#pragma unroll
            for (int e = 0; e < 8; ++e) { x[d0][e] = __uint_as_float(((unsigned)(unsigned short)qr[d0][e]) << 16); ss += x[d0][e] * x[d0][e]; }
        ss = swapsum(ss);
        const float rn = (1.0f / sqrtf(ss * (1.f / 64.f) + EPSN));
#pragma unroll
        for (int d0 = 0; d0 < 4; ++d0) { const f32x4 g0 = *(const f32x4*)(gain_q + d0 * 16 + hi * 8), g1 = *(const f32x4*)(gain_q + d0 * 16 + hi * 8 + 4);
            x[d0][0] *= rn * g0.x; x[d0][1] *= rn * g0.y; x[d0][2] *= rn * g0.z; x[d0][3] *= rn * g0.w; x[d0][4] *= rn * g1.x; x[d0][5] *= rn * g1.y; x[d0][6] *= rn * g1.z; x[d0][7] *= rn * g1.w; }
        if (!isctx) { const int t = qtok + r;
#pragma unroll
            for (int a = 0; a < 2; ++a) { const int pos = a ? (t & 63) : (t >> 6); const f32x2_t* rp = rope + pos * 16 + hi * 8;
#pragma unroll
                for (int e = 0; e < 8; ++e) { const f32x2_t cs = rp[e]; const float y0 = x[2 * a][e], y1 = x[2 * a + 1][e]; x[2 * a][e] = y0 * cs.x - y1 * cs.y; x[2 * a + 1][e] = y1 * cs.x + y0 * cs.y; } } }
#pragma unroll
        for (int d0 = 0; d0 < 4; ++d0) { u32x4 t4; t4.x = cvtpk(x[d0][0] * QSCALE, x[d0][1] * QSCALE); t4.y = cvtpk(x[d0][2] * QSCALE, x[d0][3] * QSCALE); t4.z = cvtpk(x[d0][4] * QSCALE, x[d0][5] * QSCALE); t4.w = cvtpk(x[d0][6] * QSCALE, x[d0][7] * QSCALE);
            qr[d0] = __builtin_bit_cast(bf16x8, t4); }
    }
    f32x16 o[4];
#pragma unroll
    for (int db = 0; db < 4; ++db)
#pragma unroll
        for (int i = 0; i < 16; ++i) o[db][i] = 0.f;
    float l = 0.f;
    const int lrow = tid >> 3, lch = tid & 7;
    u32x4 kA0, kA1, vA0, vA1;
#define D2_TB(j) (((j) < 4) ? ctxrow + 64 * (j) : latrow + 64 * ((j) - 4))
#define D2_LOADK(j) do { const bf16_t* kp_ = Pqk + (size_t)(D2_TB(j) + lrow) * NQK + kcol + lch * 8; kA0 = *(const u32x4*)kp_; kA1 = *(const u32x4*)(kp_ + 64); } while (0)
#define D2_LOADV(j) do { const bf16_t* vp_ = Vt + (size_t)(vrow + lrow) * MT + D2_TB(j) + lch * 8; vA0 = *(const u32x4*)vp_; vA1 = *(const u32x4*)(vp_ + (size_t)64 * MT); } while (0)
#define D2_STOREK(bf) do { LAS unsigned char* sb_ = lds + KOFF(bf); *(LAS u32x4*)(sb_ + lrow * KROW + lch * 16) = kA0; *(LAS u32x4*)(sb_ + KBUF + lrow * KROW + lch * 16) = kA1; } while (0)
#define D2_STOREV(bf) do { LAS unsigned char* vb_ = lds + VOFF(bf) + lrow * VROW + (lch >> 1) * 32 + (lch & 1) * 8; *(LAS u32x2*)vb_ = (u32x2){vA0.x, vA0.y}; *(LAS u32x2*)(vb_ + 16) = (u32x2){vA0.z, vA0.w}; \
        *(LAS u32x2*)(vb_ + 64 * VROW) = (u32x2){vA1.x, vA1.y}; *(LAS u32x2*)(vb_ + 64 * VROW + 16) = (u32x2){vA1.z, vA1.w}; } while (0)
#define D2_KFRAGS(bf, hf) do { LAS const unsigned char* Kn_ = lds + KOFF(bf) + kset * KBUF + ((hf) * 32 + r) * KROW + hi * 16; \
        kf[0] = *(LAS const bf16x8*)(Kn_); kf[1] = *(LAS const bf16x8*)(Kn_ + 32); kf[2] = *(LAS const bf16x8*)(Kn_ + 64); kf[3] = *(LAS const bf16x8*)(Kn_ + 96); } while (0)
#define D2_STEP(DONEXT, NKBF, NKHF, VBF, VHF) do { \
        LAS const unsigned char* Vb_ = lds + VOFF(VBF) + r * VROW + hi * 16 + (VHF) * 64; \
        bf16x8 va_[4][2]; \
        _Pragma("unroll") for (int db_ = 0; db_ < 4; ++db_) { va_[db_][0] = *(LAS const bf16x8*)(Vb_ + db_ * 32 * VROW); va_[db_][1] = *(LAS const bf16x8*)(Vb_ + db_ * 32 * VROW + 32); } \
        f32x16 s_; { f32x16 z_; _Pragma("unroll") for (int i_ = 0; i_ < 16; ++i_) z_[i_] = 0.f; \
            s_ = MFMA32(kf[0], qr[0], z_); s_ = MFMA32(kf[1], qr[1], s_); s_ = MFMA32(kf[2], qr[2], s_); s_ = MFMA32(kf[3], qr[3], s_); } \
        if (DONEXT) D2_KFRAGS(NKBF, NKHF); \
        _Pragma("unroll") for (int i_ = 0; i_ < 16; ++i_) s_[i_] = fexp2(s_[i_]); \
        u32x4 t0_, t1_; \
        t0_.x = cvtpk(s_[0], s_[1]); t0_.y = cvtpk(s_[2], s_[3]); t0_.z = cvtpk(s_[4], s_[5]); t0_.w = cvtpk(s_[6], s_[7]); \
        t1_.x = cvtpk(s_[8], s_[9]); t1_.y = cvtpk(s_[10], s_[11]); t1_.z = cvtpk(s_[12], s_[13]); t1_.w = cvtpk(s_[14], s_[15]); \
        const bf16x8 p0_ = __builtin_bit_cast(bf16x8, t0_), p1_ = __builtin_bit_cast(bf16x8, t1_); \
        _Pragma("unroll") for (int db_ = 0; db_ < 4; ++db_) o[db_] = MFMA32(va_[db_][0], p0_, o[db_]); \
        _Pragma("unroll") for (int db_ = 0; db_ < 4; ++db_) o[db_] = MFMA32(va_[db_][1], p1_, o[db_]); \
        float a_ = 0.f; _Pragma("unroll") for (int i_ = 0; i_ < 16; ++i_) a_ += s_[i_]; \
        l += a_; } while (0)
    D2_LOADK(0); D2_STOREK(0); D2_LOADV(0); D2_STOREV(0); D2_LOADK(1); D2_STOREK(1);
    __syncthreads();
    bf16x8 kf[4];
    D2_KFRAGS(0, 0);
    for (int j = 0; j < NT - 1; ++j) {
        if (j + 2 < NT) D2_LOADK(j + 2);
        D2_LOADV(j + 1);
        D2_STEP(true, j & 1, 1, j & 1, 0);
        D2_STEP(true, (j + 1) & 1, 0, j & 1, 1);
        if (j + 2 < NT) D2_STOREK(j & 1);
        D2_STOREV((j + 1) & 1);
        __syncthreads();
    }
    { const int j = NT - 1;
        D2_STEP(true, j & 1, 1, j & 1, 0);
        D2_STEP(false, 0, 0, j & 1, 1);
        __syncthreads(); }
#undef D2_TB
#undef D2_LOADK
#undef D2_LOADV
#undef D2_STOREK
#undef D2_STOREV
#undef D2_KFRAGS
#undef D2_STEP
    const float inv = 1.0f / swapsum(l);
    LAS float* ex = (LAS float*)lds + (size_t)wq * 64 * 64 + lane;
    if (kset == 1) {
#pragma unroll
        for (int db = 0; db < 4; ++db)
#pragma unroll
            for (int i = 0; i < 16; ++i) ex[(db * 16 + i) * 64] = o[db][i] * inv;
    }
    __syncthreads();
    if (kset == 0) {
        const float lam = lamp[0], lam_init = (layer_i == 0) ? 0.2f : 0.35550906759f;
        float ss = 0.f;
#pragma unroll
        for (int db = 0; db < 4; ++db)
#pragma unroll
            for (int i = 0; i < 16; ++i) { const float v = o[db][i] * inv - lam * ex[(db * 16 + i) * 64]; o[db][i] = v; ss += v * v; }
        ss = swapsum(ss);
        const float rs = (1.0f / sqrtf(ss * (1.f / 128.f) + EPSN)) * (1.f - lam_init);
        bf16_t* yrow = Ymix + (size_t)(qrow0 + r) * 512 + h * 128 + 4 * hi;
#pragma unroll
        for (int db = 0; db < 4; ++db)
#pragma unroll
            for (int g = 0; g < 4; ++g) { const int d = 32 * db + 8 * g; bf16_t* yp = yrow + d; const u32x2 gt = *(const u32x2*)yp; const f32x4 sl = *(const f32x4*)(subln + d + 4 * hi);
                u32x2 ov; ov.x = cvtpk(o[db][4 * g] * rs * sl.x * bflo(gt.x), o[db][4 * g + 1] * rs * sl.y * bfhi(gt.x));
                ov.y = cvtpk(o[db][4 * g + 2] * rs * sl.z * bflo(gt.y), o[db][4 * g + 3] * rs * sl.w * bfhi(gt.y));
                *(u32x2*)yp = ov; }
    }
    __syncthreads();
}

DI void attn_phase(LAS unsigned char* lds, const Params& P, int layer, int v, int G, bool dry, int tid) {
    unsigned char* ws = P.ws;
    const bf16_t* Pqk = (const bf16_t*)(ws + WS_PQK); const bf16_t* Vt = (const bf16_t*)(ws + WS_VT); bf16_t* Y = (bf16_t*)(ws + WS_Y);
    const f32x2_t* rope = (const f32x2_t*)(ws + WS_ROPE);
    const int nu = 512 + (layer == 0 ? 16 : 0);
#define ATT_DECODE(i, NH, NQB) int b_, h_, qb_; bool ic_ = false; if ((i) < 512) { b_ = (i) >> 8; h_ = ((i) / (NQB)) % (NH); qb_ = (i) % (NQB); } \
        else { const int k_ = (i) - 512; ic_ = true; b_ = k_ >> 3; if ((NH) == 4) { h_ = (k_ & 7) >> 1; qb_ = k_ & 1; } else { h_ = k_ & 7; qb_ = 0; } }
#if !defined(ATT_ONLY) || ATT_ONLY == 3
    { const float mfix = fmaxf(0.f, ((const float*)(ws + WS_LAM))[4 + layer * 4 + 3] - 100.0f); bf16_t* Ym = Y + (size_t)3 * MT * 512; const float* gq = P.qk_gain + layer * 512 + 3 * 128;
      if (mfix == 0.f) { for (int i = v; i < nu; i += G) { ATT_DECODE(i, 4, 64);
        attn_unit_d2(lds, Pqk, Vt, Ym, b_, h_, qb_, ic_, tid, gq, rope, (const float*)(ws + WS_LAM) + layer, layer, P.subln_d + layer * 128); } }
      else { for (int i = v; i < nu; i += G) { ATT_DECODE(i, 4, 64);
        attn_unit<3, false>(lds, Pqk, Vt, Ym, b_, h_, qb_, ic_, 0.f, nullptr, (const float*)(ws + WS_LAM) + layer, layer, P.subln_d + layer * 128, dry, 0.f, tid, gq, rope); } } }
#endif
#if !defined(ATT_ONLY) || ATT_ONLY == 2
    { const float mfix = fmaxf(0.f, ((const float*)(ws + WS_LAM))[4 + layer * 4 + 2] - 100.0f); bf16_t* Ym = Y + (size_t)2 * MT * 512; const float* gq = P.qk_gain + layer * 512 + 2 * 128;
      if (mfix == 0.f) { const int nu2 = 256 + (layer == 0 ? 8 : 0);
        for (int i = (v + 32) % G; i < nu2; i += G) { int b_, hp_, qb_; bool ic_ = false; if (i < 256) { b_ = i >> 7; hp_ = (i >> 5) & 3; qb_ = i & 31; } else { const int k_ = i - 256; ic_ = true; b_ = k_ >> 2; hp_ = k_ & 3; qb_ = 0; }
          attn_unit_c2(lds, Pqk, Vt, Ym, b_, hp_, qb_, ic_, dry, tid, gq, rope); } }
      else { for (int i = (v + 32) % G; i < nu; i += G) { ATT_DECODE(i, 8, 32);
        attn_unit<2, false>(lds, Pqk, Vt, Ym, b_, h_, qb_, ic_, 0.f, nullptr, nullptr, 0, nullptr, dry, 0.f, tid, gq, rope); } } }
#endif
#if !defined(ATT_ONLY) || ATT_ONLY == 0
    { bf16_t* Ym = Y; const float* gq = P.qk_gain + layer * 512;
      for (int i = (v + 64) % G; i < nu; i += G) { ATT_DECODE(i, 8, 32);
        attn_unit<0, false>(lds, Pqk, Vt, Ym, b_, h_, qb_, ic_, P.sink_a[layer * 8 + h_] * LOG2E, nullptr, nullptr, 0, nullptr, dry, 0.f, tid, gq, rope); } }
#endif
#if !defined(ATT_ONLY) || ATT_ONLY == 1
    { bf16_t* Ym = Y + (size_t)1 * MT * 512; const float* gq = P.qk_gain + layer * 512 + 1 * 128;
      for (int i = (v + 96) % G; i < nu; i += G) { ATT_DECODE(i, 8, 32);
        attn_unit<1, false>(lds, Pqk, Vt, Ym, b_, h_, qb_, ic_, 0.f, P.rpb_b + (size_t)(layer * 8 + h_) * 465, nullptr, 0, nullptr, dry, 0.f, tid, gq, rope); } }
#endif
#undef ATT_DECODE
}

#define XB_TMO      128
#define XB_XCNT(j)  (256  + 64 * (j))
#define XB_XSUB(j)  (1280 + 64 * (j))
#define XB_XGEN(j)  (2304 + 64 * (j))
#define XB_TOP      3328
#define XB_TOPGEN   3392
#define XCD_BAR_WORDS 3456
#define XB_SPIN_CAP (1u << 18)

__device__ __forceinline__ unsigned xb_ld(unsigned* p)              { return __hip_atomic_load(p, __ATOMIC_RELAXED, __HIP_MEMORY_SCOPE_AGENT); }
__device__ __forceinline__ unsigned xb_add(unsigned* p, unsigned v) { return __hip_atomic_fetch_add(p, v, __ATOMIC_RELAXED, __HIP_MEMORY_SCOPE_AGENT); }
__device__ __forceinline__ unsigned xb_xcc_id() { return (unsigned)__builtin_amdgcn_s_getreg((3 << 11) | 20) & 0xFu; }
#define XB_SPIN(cond, bar) do { unsigned _sp = 0; while (cond) { __builtin_amdgcn_s_sleep(1); \
    if ((++_sp & 255u) == 0u) { if (xb_ld(&(bar)[XB_TMO])) break; if (_sp > XB_SPIN_CAP) { atomicAdd(&(bar)[XB_TMO], 1u); break; } } } } while (0)

struct XcdBarrier {
    unsigned* bar; unsigned x;
    volatile LAS unsigned* st;
};

__device__ __forceinline__ XcdBarrier xcd_barrier_post(unsigned* bar, volatile LAS unsigned* st, int tid) {
    XcdBarrier b; b.bar = bar; b.x = xb_xcc_id(); b.st = st;
    if (tid == 0) (void)xb_add(&bar[XB_XCNT(b.x)], 1u);
    return b;
}
__device__ __forceinline__ void xcd_barrier_complete(unsigned* bar, unsigned x, unsigned& nloc, unsigned& nx) {
    const unsigned G = gridDim.x * gridDim.y * gridDim.z;
    unsigned sum, cnt, mine, sp = 0u;
    for (;;) {
        sum = 0u; cnt = 0u; mine = 0u;
#pragma unroll
        for (unsigned j = 0; j < 16; ++j) { const unsigned c = xb_ld(&bar[XB_XCNT(j)]); sum += c; cnt += (c > 0u) ? 1u : 0u; mine = (j == x) ? c : mine; }
        if (sum == G) break;
        __builtin_amdgcn_s_sleep(1);
        if ((++sp & 255u) == 0u) { if (xb_ld(&bar[XB_TMO])) break; if (sp > XB_SPIN_CAP) { atomicAdd(&bar[XB_TMO], 1u); break; } }
    }
    nloc = mine > 0u ? mine : 1u; nx = cnt > 0u ? cnt : 1u;
}

__device__ __forceinline__ void xcd_barrier(const XcdBarrier& b, int tid) {
    asm volatile("s_waitcnt vmcnt(0)" ::: "memory");
    __syncthreads();
    if (tid == 0) {
        unsigned* bar = b.bar;
        __builtin_amdgcn_s_waitcnt(0);
        unsigned nloc = b.st[0], nx = b.st[1];
        if (nloc == 0u) { xcd_barrier_complete(bar, b.x, nloc, nx); b.st[0] = nloc; b.st[1] = nx; }
        const unsigned old = xb_add(&bar[XB_XSUB(b.x)], 1u);
        const unsigned gen = old / nloc;
        if (old + 1u == (gen + 1u) * nloc) {
            __builtin_amdgcn_fence(__ATOMIC_RELEASE, "agent");
            asm volatile("s_waitcnt vmcnt(0)" ::: "memory");
            const unsigned og = xb_add(&bar[XB_TOP], 1u);
            const unsigned tg = og / nx;
            if (og + 1u == (tg + 1u) * nx) xb_add(&bar[XB_TOPGEN], 1u);
            else XB_SPIN(xb_ld(&bar[XB_TOPGEN]) == tg, bar);
            __builtin_amdgcn_fence(__ATOMIC_ACQUIRE, "agent");
            xb_add(&bar[XB_XGEN(b.x)], 1u);
            asm volatile("s_waitcnt vmcnt(0)" ::: "memory");
        } else {
            XB_SPIN(xb_ld(&bar[XB_XGEN(b.x)]) == gen, bar);
            __builtin_amdgcn_fence(__ATOMIC_ACQUIRE, "agent");
            asm volatile("s_waitcnt vmcnt(0)" ::: "memory");
        }
    }
    __syncthreads();
}

constexpr int NPHASE = 15;
__global__ void __launch_bounds__(NTHREADS, 2) dit_fwd(Params P0) {
    extern __shared__ __attribute__((aligned(16))) unsigned char lds_raw[];
    LAS unsigned char* lds = (LAS unsigned char*)lds_raw;
    cg::grid_group grid = cg::this_grid();
    const int G = gridDim.x;
    const int ph_lo = P0.ph_lo, ph_hi = P0.ph_hi;
    const int wave0 = __builtin_amdgcn_readfirstlane((int)threadIdx.x >> 6);
    { const int t0 = wave0 * 64 + (int)__builtin_amdgcn_mbcnt_hi(~0u, __builtin_amdgcn_mbcnt_lo(~0u, 0u)); if (t0 < 2) ((volatile LAS unsigned*)(lds + LDS_MISC))[t0] = 0u; }
    __syncthreads();
    if (ph_hi > 1000) grid.sync();
    XcdBarrier bar = xcd_barrier_post((unsigned*)(P0.ws + WS_BAR), (volatile LAS unsigned*)(lds + LDS_MISC), wave0 * 64 + (int)__builtin_amdgcn_mbcnt_hi(~0u, __builtin_amdgcn_mbcnt_lo(~0u, 0u)));
    for (int ph = ph_lo; ph < ph_hi; ++ph) {
        int wv_op = wave0, bid_op = blockIdx.x; asm volatile("" : "+s"(wv_op), "+s"(bid_op));
        unsigned all1 = ~0u; asm volatile("" : "+s"(all1));
        int tid_op = wv_op * 64 + (int)__builtin_amdgcn_mbcnt_hi(all1, __builtin_amdgcn_mbcnt_lo(all1, 0u)); asm volatile("" : "+v"(tid_op));
        if (ph > ph_lo) xcd_barrier(bar, tid_op);
        typedef const Params __attribute__((address_space(4)))* KArgPtr;
        KArgPtr pp = (KArgPtr)__builtin_amdgcn_kernarg_segment_ptr(); asm volatile("" : "+s"(pp));
        Params P; P.x = pp->x; P.c = pp->c; P.ctx = pp->ctx; P.c_ctx = pp->c_ctx; P.norm_w = pp->norm_w; P.w_ada = pp->w_ada; P.b_ada = pp->b_ada; P.w_in = pp->w_in; P.qk_gain = pp->qk_gain;
        P.sink_a = pp->sink_a; P.rpb_b = pp->rpb_b; P.lam_d = pp->lam_d; P.subln_d = pp->subln_d; P.w_br = pp->w_br; P.w_out = pp->w_out; P.out = pp->out; P.ws = pp->ws; P.ph_lo = 0; P.ph_hi = 0;
        unsigned char* ws = P.ws;
        const int tid = tid_op, bid = bid_op, wave = __builtin_amdgcn_readfirstlane(tid >> 6);
        const int vcu = (G % 8 == 0) ? (bid % 8) * (G / 8) + bid / 8 : bid;
        const int gw = bid * NWAVES + wave, NGW = G * NWAVES;
        const int layer = (ph - 1) / 7, sub = (ph - 1) % 7;
        const float* modl = (const float*)(ws + WS_MOD) + layer * 3 * 3072;
        const float* xcur = (layer == 0) ? P.x : P.out; const float* ccur = (layer == 0) ? P.ctx : (const float*)(ws + WS_CTX1);
        bf16_t* H = (bf16_t*)(ws + WS_H);
        bf16_t* WinT = (bf16_t*)(ws + WS_WIN) + (size_t)layer * NINC * DM;
        const int Ml = (layer == 0) ? MT : MX;
        if (ph == 0) {
#ifndef NO_PRO
            prologue_phase(P, lds, bid, G, tid, (tid & 63), wave);
#ifdef PROBE_MISC
            __syncthreads(); prologue_phase(P, lds, bid, G, tid, (tid & 63), wave);
#endif
#endif
        } else if (sub == 0) {
#ifndef NO_NORM
            norm_phase(xcur, ccur, P.norm_w + layer * DM, modl, H, gw, NGW, (tid & 63));
#ifdef PROBE_MISC
            norm_phase(xcur, ccur, P.norm_w + layer * DM, modl, H, gw, NGW, (tid & 63));
#endif
#endif
        } else if (sub == 2) {
#ifndef NO_PREP
#ifdef PROBE_MISC
            prep_phase((bf16_t*)(ws + WS_PQK), P.qk_gain + layer * 512, (const f32x2_t*)(ws + WS_ROPE), gw, NGW, (tid & 63), ph_hi < 100);
#endif
            prep_phase((bf16_t*)(ws + WS_PQK), P.qk_gain + layer * 512, (const f32x2_t*)(ws + WS_ROPE), gw, NGW, (tid & 63), false);
#endif
        } else if (sub == 3) {
#ifndef NO_ATT
#ifdef PROBE_ATT
            attn_phase(lds, P, layer, vcu, G, ph_hi < 100, tid);
            __syncthreads();
#endif
            attn_phase(lds, P, layer, vcu, G, false, tid);
#endif
        } else if (sub == 1 || sub == 4) {
#if !defined(GEMM_ONLY) || GEMM_ONLY == 1
            if (sub == 1) {
                pg8::Gemm g; EpiAct E; g.K = DM; g.A = H; g.Bt = WinT; g.M = MT; g.N = R_G;
                E.mode = 0; E.O = (bf16_t*)(ws + WS_PQK); E.ldc = NQK; E.act = 0; E.Y = (bf16_t*)(ws + WS_Y); E.VT = (bf16_t*)(ws + WS_VT);
                InProjOrder S; S.init(G, bid, layer); E.offa = S.offa; E.offb = S.offb;
#ifdef PROBE_GEMM
                for (int rep = 0; rep < 2; ++rep)
#endif
                pg8::gemm_phase<EpiAct, InProjOrder, true, true, 1024>(lds, g, S, E, tid);
            } else {
                pg8::Gemm g; EpiAct E; g.K = DM; g.A = H; g.Bt = WinT + (size_t)R_G * DM; g.M = Ml; g.N = 4096;
                E.mode = 1; E.O = (bf16_t*)(ws + WS_G); E.ldc = 4096; E.act = 2; E.Y = nullptr; E.VT = nullptr; E.offa = 0; E.offb = 0;
                pg8::StaticOrder S; S.init(g.M, g.N, G, bid);
                pg8::gemm_phase<EpiAct, pg8::StaticOrder, true, true, 1024>(lds, g, S, E, tid);
            }
#endif
        } else if (sub == 5) {
#if !defined(GEMM_ONLY) || GEMM_ONLY == 5
            pg8::Gemm g; g.A = (bf16_t*)(ws + WS_Y); g.Bt = (bf16_t*)(ws + WS_WBR) + (size_t)(layer * 4) * 1024 * 512; g.M = Ml; g.N = DM; g.K = 512;
            EpiMerge E; E.O = H; E.G0 = (const bf16_t*)(ws + WS_G);
            MergeOrder S; S.init(g.M, G, bid);
            pg8::gemm_phase<EpiMerge, MergeOrder, true, true, 512>(lds, g, S, E, tid);
            if (layer == 0) {
                const int nbusy = (264 > G && 264 - G < G) ? 264 - G : 0;
                if (bid >= nbusy) weight_copies(P, lds, 1, (bid - nbusy) * NWAVES + wave, (G - nbusy) * NWAVES, wave, tid & 63);
            }
#endif
        } else {
#if !defined(GEMM_ONLY) || GEMM_ONLY == 6
            pg8::Gemm g; g.A = H; g.Bt = (bf16_t*)(ws + WS_WOUT) + (size_t)layer * DM * DM; g.M = Ml; g.N = DM; g.K = DM;
            EpiOut E; E.xres = xcur; E.xout = P.out; E.cres = ccur; E.cout = (float*)(ws + WS_CTX1); E.modl = modl;
            pg8::StaticOrder S; S.init(g.M, g.N, G, bid);
            pg8::gemm_phase<EpiOut, pg8::StaticOrder, true, true, 1024>(lds, g, S, E, tid);
#endif
        }
    }
}

extern "C" void kernel_launch(void* const* d_in, const int* in_sizes, int n_in, void* d_out, int out_size, void* d_ws, size_t ws_size, hipStream_t stream) {
    static int grid = 0;
    if (grid == 0) {
        if (n_in != 15 || out_size != MX * DM || ws_size < WS_END) { fprintf(stderr, "kernel_launch: unexpected shapes (n_in %d out %d ws %zu, need %zu)\n", n_in, out_size, ws_size, (size_t)WS_END); grid = -1; return; }
        int dev = 0, cus = 0, per_cu = 0;
        hipGetDevice(&dev); hipDeviceGetAttribute(&cus, hipDeviceAttributeMultiprocessorCount, dev);
        if (hipFuncSetAttribute((const void*)dit_fwd, hipFuncAttributeMaxDynamicSharedMemorySize, LDS_BYTES) != hipSuccess) { fprintf(stderr, "kernel_launch: hipFuncSetAttribute failed\n"); grid = -1; return; }
        if (hipOccupancyMaxActiveBlocksPerMultiprocessor(&per_cu, (const void*)dit_fwd, NTHREADS, LDS_BYTES) != hipSuccess || per_cu < 1) { fprintf(stderr, "kernel_launch: occupancy query failed (%d)\n", per_cu); (void)hipGetLastError(); grid = -1; return; }
        grid = cus * 1;
    }
    if (grid < 0) return;
    Params p{};
    p.x = (const float*)d_in[0]; p.c = (const float*)d_in[1]; p.ctx = (const float*)d_in[2]; p.c_ctx = (const float*)d_in[3]; p.norm_w = (const float*)d_in[4];
    p.w_ada = (const float*)d_in[5]; p.b_ada = (const float*)d_in[6]; p.w_in = (const float*)d_in[7]; p.qk_gain = (const float*)d_in[8]; p.sink_a = (const float*)d_in[9];
    p.rpb_b = (const float*)d_in[10]; p.lam_d = (const float*)d_in[11]; p.subln_d = (const float*)d_in[12]; p.w_br = (const float*)d_in[13]; p.w_out = (const float*)d_in[14];
    p.out = (float*)d_out; p.ws = (unsigned char*)d_ws;
    if (hipMemsetAsync((char*)d_ws + WS_BAR, 0, 16384, stream) != hipSuccess) { fprintf(stderr, "kernel_launch: memset failed\n"); return; }
#ifdef MULTI_LAUNCH
    for (int ph = 0; ph < NPHASE; ++ph) { p.ph_lo = ph; p.ph_hi = ph + 1; hipLaunchKernelGGL(dit_fwd, dim3(grid), dim3(NTHREADS), LDS_BYTES, stream, p); }
#else
    p.ph_lo = 0; p.ph_hi = NPHASE;
    void* args[] = {&p};
    hipError_t e = hipLaunchCooperativeKernel((const void*)dit_fwd, dim3(grid), dim3(NTHREADS), args, LDS_BYTES, stream);
    if (e != hipSuccess) fprintf(stderr, "kernel_launch: cooperative launch failed: %s (grid %d)\n", hipGetErrorString(e), grid);
#endif
}
```
